# Optimizing an MI355X kernel written in HIP

```python
import jax, jax.numpy as jnp
from jax import lax
import numpy as np

D_MODEL = 1024
BATCH = 32
SEQ = 2048
DEPTH = 1

HEAD_DIM = 64
N_HEADS = D_MODEL // HEAD_DIM
N_HEADS_B = N_HEADS // 4
N_HEADS_A = N_HEADS - N_HEADS_B
WIDTH_A = N_HEADS_A * HEAD_DIM
WIDTH_B = N_HEADS_B * HEAD_DIM
MIX_WIDTH = WIDTH_A + WIDTH_B
DILATED_CONFIGS = ((128, 1), (512, 4), (2048, 16))
MOBA_BLOCK = 256
MOBA_TOPK = 3
D_FF = 2816
LN_EPS = 1e-5

kernel_name = 'hybrid_dilated_moba_macaron_deepnorm'


def layer_norm(x, g, b):
    xf = x.astype(jnp.float32)
    mu = jnp.mean(xf, axis=-1, keepdims=True)
    var = jnp.mean(jnp.square(xf - mu), axis=-1, keepdims=True)
    y = (xf - mu) * lax.rsqrt(var + LN_EPS)
    return (y * g.astype(jnp.float32) + b.astype(jnp.float32)).astype(x.dtype)


def swiglu(h, w_gate, w_up, w_down):
    return (jax.nn.silu(h @ w_gate) * (h @ w_up)) @ w_down


def alibi_slopes():
    idx = np.arange(N_HEADS)
    slopes = 2.0 ** (-8.0 * (idx + 1) / N_HEADS)
    is_b = (idx % 4) == 3
    return (jnp.asarray(slopes[~is_b], dtype=jnp.float32),
            jnp.asarray(slopes[is_b], dtype=jnp.float32))


def dilated_branch(q, k, v, slopes, window, dilation):
    H, S, Dh = q.shape
    d = dilation
    C = window // d
    s_sub = S // d
    nb = -(-s_sub // C)
    L = nb * C

    def to_sub(t):
        return t.reshape(H, s_sub, d, Dh).transpose(0, 2, 1, 3)

    qs, ks, vs = to_sub(q), to_sub(k), to_sub(v)
    qs = jnp.pad(qs, ((0, 0), (0, 0), (0, L - s_sub), (0, 0))).reshape(H, d, nb, C, Dh)

    def band(t):
        tp = jnp.pad(t, ((0, 0), (0, 0), (C, L - s_sub), (0, 0))).reshape(H, d, nb + 1, C, Dh)
        return jnp.concatenate([tp[:, :, :-1], tp[:, :, 1:]], axis=3)

    kw, vw = band(ks), band(vs)
    a = jnp.arange(C)[:, None]
    j = jnp.arange(2 * C)[None, :]
    delta = a + C - j
    key_sub = jnp.arange(nb)[:, None, None] * C - C + j
    valid = (delta >= 0) & (delta <= C) & (key_sub >= 0)

    s = jnp.einsum('hrnqd,hrnkd->hrnqk', qs, kw) * (Dh ** -0.5)
    s = s - slopes[:, None, None, None, None] * (delta * d).astype(jnp.float32)
    s = jnp.where(valid, s, -jnp.inf)
    m = jnp.max(s, axis=-1, keepdims=True)
    p = jnp.exp(s - m)
    l = jnp.sum(p, axis=-1, keepdims=True)
    o = jnp.einsum('hrnqk,hrnkd->hrnqd', p, vw) / l
    lse = (m + jnp.log(l))[..., 0]
    o = o.reshape(H, d, L, Dh)[:, :, :s_sub].transpose(0, 2, 1, 3).reshape(H, S, Dh)
    lse = lse.reshape(H, d, L)[:, :, :s_sub].transpose(0, 2, 1).reshape(H, S)
    return o, lse


def dilated_mixer(q, k, v, slopes):
    outs, lses = [], []
    for window, dilation in DILATED_CONFIGS:
        o, lse = dilated_branch(q, k, v, slopes, window, dilation)
        outs.append(o)
        lses.append(lse)
    wts = jax.nn.softmax(jnp.stack(lses), axis=0)
    return jnp.sum(wts[..., None] * jnp.stack(outs), axis=0)


def moba_mixer(q, k, v, slopes):
    H, S, Dh = q.shape
    Bk = MOBA_BLOCK
    nblk = -(-S // Bk)
    Sp = nblk * Bk
    n_sel = min(MOBA_TOPK, nblk - 1)
    scale = Dh ** -0.5

    def blocks(t):
        return jnp.pad(t, ((0, 0), (0, Sp - S), (0, 0))).reshape(H, nblk, Bk, Dh)

    qb, kb, vb = blocks(q), blocks(k), blocks(v)
    a = jnp.arange(Bk)
    causal = a[:, None] >= a[None, :]
    own_dist = (a[:, None] - a[None, :]).astype(jnp.float32)
    hidx = jnp.arange(H)[:, None, None]

    def own_scores(qn, kn):
        s = jnp.einsum('hqd,hkd->hqk', qn, kn) * scale - slopes[:, None, None] * own_dist
        return jnp.where(causal, s, -jnp.inf)

    if n_sel == 0:
        def step0(args):
            qn, kn, vn = args
            p = jax.nn.softmax(own_scores(qn, kn), axis=-1)
            return jnp.einsum('hqk,hkd->hqd', p, vn)
        o = lax.map(step0, (qb.transpose(1, 0, 2, 3), kb.transpose(1, 0, 2, 3), vb.transpose(1, 0, 2, 3)))
        return o.transpose(1, 0, 2, 3).reshape(H, Sp, Dh)[:, :S]

    kmean = jnp.mean(kb, axis=2)
    gate = jnp.einsum('hnqd,hmd->hnqm', qb, kmean)
    blk_ids = jnp.arange(nblk)
    past = blk_ids[None, :] < blk_ids[:, None]
    gate = jnp.where(past[None, :, None, :], gate, -jnp.inf)
    _, sel = lax.top_k(gate, n_sel)
    sel_ok = sel < blk_ids[None, :, None, None]

    def step(args):
        n, qn, kn, vn, seln, okn = args
        s_own = own_scores(qn, kn)
        kg = kb[hidx, seln]
        vg = vb[hidx, seln]
        dist = (n * Bk + a)[None, :, None, None] - (seln[..., None] * Bk + a[None, None, None, :])
        s_sel = jnp.einsum('hqd,hqskd->hqsk', qn, kg) * scale - slopes[:, None, None, None] * dist.astype(jnp.float32)
        s_sel = jnp.where(okn[..., None], s_sel, -jnp.inf)
        s_all = jnp.concatenate([s_own, s_sel.reshape(H, Bk, n_sel * Bk)], axis=-1)
        p = jax.nn.softmax(s_all, axis=-1)
        p_own = p[..., :Bk]
        p_sel = p[..., Bk:].reshape(H, Bk, n_sel, Bk)
        return jnp.einsum('hqk,hkd->hqd', p_own, vn) + jnp.einsum('hqsk,hqskd->hqd', p_sel, vg)

    xs = (blk_ids, qb.transpose(1, 0, 2, 3), kb.transpose(1, 0, 2, 3), vb.transpose(1, 0, 2, 3),
          sel.transpose(1, 0, 2, 3), sel_ok.transpose(1, 0, 2, 3))
    o = lax.map(step, xs)
    return o.transpose(1, 0, 2, 3).reshape(H, Sp, Dh)[:, :S]


def token_mixer(h, w_in, w_out):
    B, S, _ = h.shape
    proj = h @ w_in
    cuts = [WIDTH_A, 2 * WIDTH_A, 3 * WIDTH_A, 3 * WIDTH_A + WIDTH_B, 3 * WIDTH_A + 2 * WIDTH_B]
    qa, ka, va, qb, kb, vb = jnp.split(proj, cuts, axis=-1)

    def heads(t, nh):
        return t.reshape(B, S, nh, HEAD_DIM).transpose(0, 2, 1, 3).astype(jnp.float32)

    slopes_a, slopes_b = alibi_slopes()
    oa = lax.map(lambda t: dilated_mixer(t[0], t[1], t[2], slopes_a),
                 (heads(qa, N_HEADS_A), heads(ka, N_HEADS_A), heads(va, N_HEADS_A)))
    ob = lax.map(lambda t: moba_mixer(t[0], t[1], t[2], slopes_b),
                 (heads(qb, N_HEADS_B), heads(kb, N_HEADS_B), heads(vb, N_HEADS_B)))
    o = jnp.concatenate([oa.transpose(0, 2, 1, 3).reshape(B, S, WIDTH_A),
                         ob.transpose(0, 2, 1, 3).reshape(B, S, WIDTH_B)], axis=-1)
    return o.astype(h.dtype) @ w_out


def setup_inputs(seed: int = 0) -> dict:
    key = jax.random.key(seed)
    ks = jax.random.split(key, 16)
    beta = (8.0 * DEPTH) ** -0.25

    def nrm(k, shape, scale):
        return jax.random.normal(k, shape, jnp.float32) * scale

    col_scale = jnp.concatenate([
        jnp.ones((2 * WIDTH_A,), jnp.float32), jnp.full((WIDTH_A,), beta, jnp.float32),
        jnp.ones((2 * WIDTH_B,), jnp.float32), jnp.full((WIDTH_B,), beta, jnp.float32)])
    return {
        'x': nrm(ks[0], (BATCH, SEQ, D_MODEL), 1.0),
        'ffn1_gate': nrm(ks[1], (DEPTH, D_MODEL, D_FF), D_MODEL ** -0.5),
        'ffn1_up': nrm(ks[2], (DEPTH, D_MODEL, D_FF), D_MODEL ** -0.5),
        'ffn1_down': nrm(ks[3], (DEPTH, D_FF, D_MODEL), beta * D_FF ** -0.5),
        'ln1_g': 1.0 + nrm(ks[4], (DEPTH, D_MODEL), 0.05),
        'ln1_b': nrm(ks[5], (DEPTH, D_MODEL), 0.02),
        'w_in': nrm(ks[6], (DEPTH, D_MODEL, 3 * MIX_WIDTH), D_MODEL ** -0.5) * col_scale,
        'w_out': nrm(ks[7], (DEPTH, MIX_WIDTH, D_MODEL), beta * MIX_WIDTH ** -0.5),
        'ln2_g': 1.0 + nrm(ks[8], (DEPTH, D_MODEL), 0.05),
        'ln2_b': nrm(ks[9], (DEPTH, D_MODEL), 0.02),
        'ffn2_gate': nrm(ks[10], (DEPTH, D_MODEL, D_FF), D_MODEL ** -0.5),
        'ffn2_up': nrm(ks[11], (DEPTH, D_MODEL, D_FF), D_MODEL ** -0.5),
        'ffn2_down': nrm(ks[12], (DEPTH, D_FF, D_MODEL), beta * D_FF ** -0.5),
        'ln3_g': 1.0 + nrm(ks[13], (DEPTH, D_MODEL), 0.05),
        'ln3_b': nrm(ks[14], (DEPTH, D_MODEL), 0.02),
    }


def reference(x, ffn1_gate, ffn1_up, ffn1_down, ln1_g, ln1_b, w_in, w_out, ln2_g, ln2_b,
              ffn2_gate, ffn2_up, ffn2_down, ln3_g, ln3_b):
    alpha = (2.0 * DEPTH) ** 0.25
    h = x
    for l in range(DEPTH):
        h = layer_norm(alpha * h + 0.5 * swiglu(h, ffn1_gate[l], ffn1_up[l], ffn1_down[l]), ln1_g[l], ln1_b[l])
        h = layer_norm(alpha * h + token_mixer(h, w_in[l], w_out[l]), ln2_g[l], ln2_b[l])
        h = layer_norm(alpha * h + 0.5 * swiglu(h, ffn2_gate[l], ffn2_up[l], ffn2_down[l]), ln3_g[l], ln3_b[l])
    return h
```

```cpp
#include <hip/hip_runtime.h>
#include <cstdio>
#include <cstdint>
#include <cmath>
namespace pg8 {
#define PG8_LAS __attribute__((address_space(3)))
typedef unsigned short bf16_t;
typedef short bf16x8 __attribute__((ext_vector_type(8)));
typedef float f32x4 __attribute__((ext_vector_type(4)));
typedef unsigned u32x4 __attribute__((ext_vector_type(4)));
constexpr int BM = 256, BK = 64, HALF = 128, HTB = HALF * BK * 2  , STAGE_BYTES = 8 * HTB, NXCD = 8, WGM = 8;

__host__ __device__ __forceinline__ int lds_byte(int r, int c) { const int st = (r >> 4) * 2 + (c >> 5), rr = r & 15, cc = c & 31, ob = rr * 64 + cc * 2; return st * 1024 + (ob ^ (((ob >> 9) & 1) << 5)); }
__host__ __device__ __forceinline__ void stage_rc(int b, int& R, int& C) { const int st = b / 1024, sb = b % 1024, swz = sb ^ (((sb >> 9) & 1) << 5); R = (st >> 1) * 16 + swz / 64; C = (st & 1) * 32 + (swz % 64) / 2; }
__host__ __device__ __forceinline__ int perm32(int rho) { const int n = rho >> 4, i = rho & 15; return 8 * (i >> 2) + 4 * n + (i & 3); }

struct Unit { int pm, pn; };
struct Gemm { const bf16_t* A; const bf16_t* Bt; int M, N, K; };

struct StaticOrder {
    int nM, nN, nwg, G, c;
    __host__ __device__ void init(int M, int N, int G_, int c_) { nM = M / BM; nN = N / BM; nwg = nM * nN; G = G_; c = c_; }
    __host__ __device__ bool next(int i, Unit& u) const {
        const long L = (long)i * G + c; if (L >= nwg) return false;
        int wgid = (int)L; { const int q = nwg / NXCD, r = nwg % NXCD, xcd = wgid % NXCD, off = wgid / NXCD; wgid = (xcd < r ? xcd * (q + 1) : r * (q + 1) + (xcd - r) * q) + off; }
        const int nig = WGM * nN, gid = wgid / nig, fm = gid * WGM, gsz = (nM - fm) < WGM ? (nM - fm) : WGM;
        u.pm = fm + ((wgid % nig) % gsz); u.pn = (wgid % nig) / gsz; return true;
    }
    __device__ __forceinline__ void a_ready(const Unit&) const {}
    __device__ __forceinline__ void done(const Unit&) const {}
};

__device__ __forceinline__ unsigned cvt_pk_bf16(float lo, float hi) { unsigned r; asm volatile("v_cvt_pk_bf16_f32 %0, %1, %2" : "=v"(r) : "v"(lo), "v"(hi)); return r; }
typedef float f32x2 __attribute__((ext_vector_type(2)));
typedef float f32x2v __attribute__((ext_vector_type(2)));
struct EpiSwiGLU {
    static constexpr bool PERM = true, AFTER_DRAIN = false;
    bf16_t* H; int ldh;
    __device__ __forceinline__ static float silu_mul(float g, float u) { const float e = __builtin_amdgcn_exp2f(g * -1.4426950408889634f); return g * __builtin_amdgcn_rcpf(1.0f + e) * u; }
    __device__ __forceinline__ void operator()(const f32x4 (&acc)[2][2][4][2], const Unit& u, int wr, int wc, int fr, int fq) const {
        const int row0 = u.pm * BM + wr * 64 + fr, col0 = u.pn * HALF + wc * 32 + 8 * fq;
#pragma unroll
        for (int ai = 0; ai < 2; ++ai)
#pragma unroll
            for (int m = 0; m < 4; ++m) { bf16_t* rowp = H + (size_t)(row0 + ai * HALF + m * 16) * ldh + col0;
                const f32x4 g0 = acc[ai][0][m][0], g1 = acc[ai][0][m][1], u0 = acc[ai][1][m][0], u1 = acc[ai][1][m][1];
                u32x4 w; w.x = cvt_pk_bf16(silu_mul(g0[0], u0[0]), silu_mul(g0[1], u0[1])); w.y = cvt_pk_bf16(silu_mul(g0[2], u0[2]), silu_mul(g0[3], u0[3]));
                w.z = cvt_pk_bf16(silu_mul(g1[0], u1[0]), silu_mul(g1[1], u1[1])); w.w = cvt_pk_bf16(silu_mul(g1[2], u1[2]), silu_mul(g1[3], u1[3]));
                *(u32x4*)rowp = w; }
    }
};
struct EpiResF32 {
    static constexpr bool PERM = false, AFTER_DRAIN = false;
    const float* R; float* Y; int ldc; float alpha, beta;
    __device__ __forceinline__ void operator()(const f32x4 (&acc)[2][2][4][2], const Unit& u, int wr, int wc, int fr, int fq) const {
        const int row0 = u.pm * BM + wr * 64 + fr, col0 = u.pn * BM + wc * 32 + 4 * fq;
#pragma unroll
        for (int ai = 0; ai < 2; ++ai)
#pragma unroll
            for (int m = 0; m < 4; ++m) { const size_t off = (size_t)(row0 + ai * HALF + m * 16) * ldc + col0;
                f32x4 rv[2][2];
#pragma unroll
                for (int bj = 0; bj < 2; ++bj)
#pragma unroll
                    for (int n = 0; n < 2; ++n) rv[bj][n] = *(const f32x4*)(R + off + bj * HALF + n * 16);
#pragma unroll
                for (int bj = 0; bj < 2; ++bj)
#pragma unroll
                    for (int n = 0; n < 2; ++n) *(f32x4*)(Y + off + bj * HALF + n * 16) = rv[bj][n] * alpha + acc[ai][bj][m][n] * beta;
                asm volatile("" ::: "memory"); }
    }
};
struct EpiQKV {
    static constexpr bool PERM = true, AFTER_DRAIN = false;
    bf16_t* O; size_t split_stride; float scale0; float* ksum;
    __device__ __forceinline__ void operator()(const f32x4 (&acc)[2][2][4][2], const Unit& u, int wr, int wc, int fr, int fq) const {
        const int row0 = u.pm * BM + wr * 64 + fr; const int t = u.pn >> 2; const int colt = (u.pn & 3) * BM;
        bf16_t* base = O + (size_t)t * split_stride; const float sc = (t == 0) ? scale0 : 1.f;
        const int col0 = colt + wc * 32 + 8 * fq;
#pragma unroll
        for (int ai = 0; ai < 2; ++ai)
#pragma unroll
            for (int m = 0; m < 4; ++m) { bf16_t* rowp = base + (size_t)(row0 + ai * HALF + m * 16) * 1024 + col0;
#pragma unroll
                for (int bj = 0; bj < 2; ++bj) { const f32x4 v0 = acc[ai][bj][m][0] * sc, v1 = acc[ai][bj][m][1] * sc;
                    u32x4 w; w.x = cvt_pk_bf16(v0[0], v0[1]); w.y = cvt_pk_bf16(v0[2], v0[3]); w.z = cvt_pk_bf16(v1[0], v1[1]); w.w = cvt_pk_bf16(v1[2], v1[3]);
                    *(u32x4*)(rowp + bj * HALF) = w; } }
        if (u.pn == 7) {
#pragma unroll
            for (int bj = 0; bj < 2; ++bj)
#pragma unroll
                for (int n = 0; n < 2; ++n) { f32x4 s = (f32x4){0.f, 0.f, 0.f, 0.f};
#pragma unroll
                    for (int ai = 0; ai < 2; ++ai)
#pragma unroll
                        for (int m = 0; m < 4; ++m) s += acc[ai][bj][m][n];
#pragma unroll
                    for (int e = 0; e < 4; ++e) { float x = s[e]; x += __shfl_xor(x, 1); x += __shfl_xor(x, 2); x += __shfl_xor(x, 4); x += __shfl_xor(x, 8);
                        if (fr == 0) atomicAdd(ksum + (size_t)u.pm * 256 + bj * HALF + wc * 32 + 8 * fq + 4 * n + e, x); } }
        }
    }
};
template <class Epi, class Sched, bool ALIGN_EPI = false, bool SP2 = false>
__device__ __forceinline__ void gemm_phase(PG8_LAS unsigned char* lds, const Gemm g, const Sched& S, const Epi& E) {
    const int tid = threadIdx.x, wid = __builtin_amdgcn_readfirstlane(tid >> 6), lane = tid & 63, wr = wid >> 2, wc = wid & 3, fr = lane & 15, fq = lane >> 4;
    const int K = g.K, nt = K / BK;
    unsigned voffA[2], voffB[2];
#pragma unroll
    for (int i = 0; i < 2; ++i) { int R, C; stage_rc(tid * 16 + i * 8192, R, C); const int Rb = Epi::PERM ? ((R & ~31) + perm32(R & 31)) : R;
        voffA[i] = (unsigned)(R * K + C) * 2u; voffB[i] = (unsigned)(Rb * K + C) * 2u; }
    const size_t kstep = (size_t)(BK * 2);
    const size_t hstep = (size_t)HALF * K * 2;
    const size_t tstep = 2 * hstep;
    const unsigned ldsw = (unsigned)wid * 1024u;
    const int aoff = lds_byte(wr * 64 + fr, fq * 8), boff = lds_byte(wc * 32 + fr, fq * 8);
#define PG8_SA(b, h) (((b) * 2 + (h)) * HTB)
#define PG8_SB(b, h) ((4 + (b) * 2 + (h)) * HTB)
#define PG8_STAGE(bufoff, gbase, voff) do { _Pragma("unroll") for (int _i = 0; _i < 2; ++_i) \
        __builtin_amdgcn_global_load_lds((const unsigned*)((const char*)(gbase) + (voff)[_i]), (PG8_LAS unsigned*)(lds + (bufoff) + ldsw + _i * 8192), 16, 0, 0); } while (0)
#define PG8_LDA(dst, b, h) do { _Pragma("unroll") for (int m = 0; m < 4; ++m) _Pragma("unroll") for (int k = 0; k < 2; ++k) dst[m][k] = *(const PG8_LAS bf16x8*)(lds + PG8_SA(b, h) + aoff + m * 2048 + k * 1024); } while (0)
#define PG8_LDB(dst, b, h) do { _Pragma("unroll") for (int n = 0; n < 2; ++n) _Pragma("unroll") for (int k = 0; k < 2; ++k) dst[n][k] = *(const PG8_LAS bf16x8*)(lds + PG8_SB(b, h) + boff + n * 2048 + k * 1024); } while (0)
#define PG8_MMA(ai, bj, At, Bt) do { __builtin_amdgcn_s_setprio(1); _Pragma("unroll") for (int m = 0; m < 4; ++m) _Pragma("unroll") for (int n = 0; n < 2; ++n) _Pragma("unroll") for (int k = 0; k < 2; ++k) \
        acc[ai][bj][m][n] = __builtin_amdgcn_mfma_f32_16x16x32_bf16(Bt[n][k], At[m][k], acc[ai][bj][m][n], 0, 0, 0); __builtin_amdgcn_s_setprio(0); } while (0)
#define PG8_WAIT_V(n) asm volatile("s_waitcnt vmcnt(" #n ")" ::: "memory")
#define PG8_WAIT_L(n) asm volatile("s_waitcnt lgkmcnt(" #n ")" ::: "memory")
#define PG8_BAR __builtin_amdgcn_s_barrier()
#define PG8_SCHED __builtin_amdgcn_sched_barrier(0)
    Unit cur, nxt; int ui = 0;
    if (!S.next(0, cur)) return;
    f32x4 acc[2][2][4][2];
#pragma unroll
    for (int a = 0; a < 2; ++a)
#pragma unroll
        for (int b = 0; b < 2; ++b)
#pragma unroll
            for (int m = 0; m < 4; ++m)
#pragma unroll
                for (int n = 0; n < 2; ++n) acc[a][b][m][n] = (f32x4){0.f, 0.f, 0.f, 0.f};
    bf16x8 At[4][2], B0[2][2], B1[2][2];
    const char* cA = (const char*)g.A + (size_t)cur.pm * tstep; const char* cB = (const char*)g.Bt + (size_t)cur.pn * tstep;
    S.a_ready(cur);
    if constexpr (SP2) {
        PG8_STAGE(PG8_SB(0, 0), cB, voffB); PG8_STAGE(PG8_SB(0, 1), cB + hstep, voffB); PG8_STAGE(PG8_SA(0, 0), cA, voffA); PG8_STAGE(PG8_SA(0, 1), cA + hstep, voffA);
        if (wr == 1) PG8_BAR;
        PG8_WAIT_V(2); PG8_BAR;
        PG8_STAGE(PG8_SB(1, 0), cB + kstep, voffB); PG8_STAGE(PG8_SA(1, 0), cA + kstep, voffA); PG8_STAGE(PG8_SB(1, 1), cB + hstep + kstep, voffB);
        PG8_WAIT_V(6); PG8_BAR;
    } else {
        PG8_STAGE(PG8_SB(0, 0), cB, voffB); PG8_STAGE(PG8_SA(0, 0), cA, voffA); PG8_STAGE(PG8_SB(0, 1), cB + hstep, voffB); PG8_STAGE(PG8_SA(0, 1), cA + hstep, voffA);
        if (wr == 1) PG8_BAR;
        PG8_WAIT_V(4); PG8_BAR;
        PG8_STAGE(PG8_SB(1, 0), cB + kstep, voffB); PG8_STAGE(PG8_SA(1, 0), cA + kstep, voffA); PG8_STAGE(PG8_SB(1, 1), cB + hstep + kstep, voffB);
        PG8_WAIT_V(6); PG8_BAR;
    }
    for (;;) {
        const bool has_next = S.next(ui + 1, nxt);
        const char* nA = has_next ? (const char*)g.A + (size_t)nxt.pm * tstep : cA; const char* nB = has_next ? (const char*)g.Bt + (size_t)nxt.pn * tstep : cB;
        for (int t = 0; t < nt; t += 2) {
            const bool last = (t == nt - 2);
            const char* a1 = cA + (size_t)(t + 1) * kstep;
            const char* a2 = last ? nA : cA + (size_t)(t + 2) * kstep; const char* b2 = last ? nB : cB + (size_t)(t + 2) * kstep;
            const char* a3 = a2 + kstep; const char* b3 = b2 + kstep;
            if (last && has_next) S.a_ready(nxt);
            if constexpr (SP2) {
            PG8_LDB(B0, 0, 0); PG8_LDB(B1, 0, 1); PG8_SCHED; PG8_LDA(At, 0, 0); PG8_STAGE(PG8_SA(1, 1), a1 + hstep, voffA);
            PG8_WAIT_V(8); PG8_WAIT_L(0); PG8_BAR; PG8_MMA(0, 0, At, B0); PG8_MMA(0, 1, At, B1); PG8_BAR; PG8_SCHED;
            PG8_LDA(At, 0, 1); PG8_STAGE(PG8_SB(0, 0), b2, voffB); PG8_STAGE(PG8_SB(0, 1), b2 + hstep, voffB); PG8_STAGE(PG8_SA(0, 0), a2, voffA);
            PG8_WAIT_V(8); PG8_WAIT_L(0); PG8_BAR; PG8_MMA(1, 0, At, B0); PG8_MMA(1, 1, At, B1); PG8_BAR; PG8_SCHED;
            PG8_LDB(B0, 1, 0); PG8_LDB(B1, 1, 1); PG8_SCHED; PG8_LDA(At, 1, 0); PG8_STAGE(PG8_SA(0, 1), a2 + hstep, voffA);
            PG8_WAIT_V(8); PG8_WAIT_L(0); PG8_BAR; PG8_MMA(0, 0, At, B0); PG8_MMA(0, 1, At, B1); PG8_BAR; PG8_SCHED;
            PG8_LDA(At, 1, 1); PG8_STAGE(PG8_SB(1, 0), b3, voffB); PG8_STAGE(PG8_SB(1, 1), b3 + hstep, voffB); PG8_STAGE(PG8_SA(1, 0), a3, voffA);
            PG8_WAIT_V(8); PG8_WAIT_L(0); PG8_BAR; PG8_MMA(1, 0, At, B0); PG8_MMA(1, 1, At, B1); PG8_BAR; PG8_SCHED;
            } else {
            PG8_LDB(B0, 0, 0); PG8_SCHED; PG8_LDA(At, 0, 0); PG8_STAGE(PG8_SA(1, 1), a1 + hstep, voffA);
            PG8_WAIT_L(8); PG8_BAR; PG8_WAIT_L(0); PG8_MMA(0, 0, At, B0); PG8_BAR; PG8_SCHED;
            PG8_LDB(B1, 0, 1); PG8_STAGE(PG8_SB(0, 0), b2, voffB);
            PG8_BAR; PG8_WAIT_L(0); PG8_MMA(0, 1, At, B1); PG8_BAR;
            PG8_LDA(At, 0, 1); PG8_STAGE(PG8_SA(0, 0), a2, voffA);
            PG8_BAR; PG8_WAIT_L(0); PG8_MMA(1, 0, At, B0); PG8_BAR; PG8_SCHED;
            PG8_STAGE(PG8_SB(0, 1), b2 + hstep, voffB);
            PG8_WAIT_V(6); PG8_BAR; PG8_MMA(1, 1, At, B1); PG8_BAR;
            PG8_LDB(B0, 1, 0); PG8_SCHED; PG8_LDA(At, 1, 0); PG8_STAGE(PG8_SA(0, 1), a2 + hstep, voffA);
            PG8_WAIT_L(8); PG8_BAR; PG8_WAIT_L(0); PG8_MMA(0, 0, At, B0); PG8_BAR; PG8_SCHED;
            PG8_LDB(B1, 1, 1); PG8_STAGE(PG8_SB(1, 0), b3, voffB);
            PG8_BAR; PG8_WAIT_L(0); PG8_MMA(0, 1, At, B1); PG8_BAR;
            PG8_LDA(At, 1, 1); PG8_STAGE(PG8_SA(1, 0), a3, voffA);
            PG8_BAR; PG8_WAIT_L(0); PG8_MMA(1, 0, At, B0); PG8_BAR; PG8_SCHED;
            PG8_STAGE(PG8_SB(1, 1), b3 + hstep, voffB);
            PG8_WAIT_V(6); PG8_BAR; PG8_MMA(1, 1, At, B1); PG8_BAR;
            }
        }
        if constexpr (ALIGN_EPI) { if (wr == 0) PG8_BAR; }
        if constexpr (!Epi::AFTER_DRAIN) { E(acc, cur, wr, wc, fr, fq); S.done(cur); }
        if (!has_next) break;
#pragma unroll
        for (int a = 0; a < 2; ++a)
#pragma unroll
            for (int b = 0; b < 2; ++b)
#pragma unroll
                for (int m = 0; m < 4; ++m)
#pragma unroll
                    for (int n = 0; n < 2; ++n) acc[a][b][m][n] = (f32x4){0.f, 0.f, 0.f, 0.f};
        cur = nxt; cA = nA; cB = nB; ++ui;
        if constexpr (ALIGN_EPI) { if (wr == 1) PG8_BAR; }
    }
    PG8_WAIT_V(0);
    if constexpr (!ALIGN_EPI) { if (wr == 0) PG8_BAR; }
    PG8_BAR;
    if constexpr (Epi::AFTER_DRAIN) { E.fused(acc, cur, wr, wc, fr, fq, lds, wid, lane); S.done(cur); }
#undef PG8_SA
#undef PG8_SB
#undef PG8_STAGE
#undef PG8_LDA
#undef PG8_LDB
#undef PG8_MMA
#undef PG8_WAIT_V
#undef PG8_WAIT_L
#undef PG8_BAR
#undef PG8_SCHED
}
}
#ifndef PG8_SP2
#define PG8_SP2 true
#endif
#ifndef PG8_ALIGN
#define PG8_ALIGN true
#endif
constexpr int NWAVES = 8;
constexpr int BATCH = 32, SEQ = 2048, D = 1024, FF = 2816, NGU = 2 * FF, NQKV = 3 * D, HD = 64;
constexpr int M = BATCH * SEQ;
constexpr int NHA = 12, NHB = 4, WIDTH_A = NHA * HD, WIDTH_B = NHB * HD;
constexpr float LN_EPS = 1e-5f;
constexpr float ALPHA = 1.189207115002721f;
constexpr float QSCALE = 0.125f * 1.4426950408889634f;
constexpr size_t MiB = 1u << 20;
constexpr size_t WS_CTL = 0, WS_KS = 1 * MiB, CTL_ZERO_BYTES = 2 * MiB;
constexpr size_t WS_W1T = 2 * MiB, WS_W2T = 13 * MiB, WS_WINT = 19 * MiB, WS_WOT = 25 * MiB, WS_W3T = 27 * MiB, WS_W4T = 38 * MiB;
constexpr size_t WS_XB = 64 * MiB;
constexpr size_t WS_Y = 192 * MiB;
constexpr size_t WS_R1 = 448 * MiB;
constexpr size_t WS_OB = 832 * MiB;
constexpr size_t WS_END = 960 * MiB;
static_assert(WS_W1T + (size_t)NGU * D * 2 <= WS_W2T && WS_W2T + (size_t)D * FF * 2 <= WS_WINT && WS_WINT + (size_t)NQKV * D * 2 <= WS_WOT && WS_WOT + (size_t)D * D * 2 <= WS_W3T &&
              WS_W3T + (size_t)NGU * D * 2 <= WS_W4T && WS_W4T + (size_t)D * FF * 2 <= WS_XB && WS_XB + (size_t)M * D * 2 <= WS_Y && WS_Y + (size_t)M * D * 4 <= WS_R1 &&
              WS_R1 + (size_t)3 * M * D * 2 <= WS_OB && WS_R1 + (size_t)M * FF * 2 <= WS_OB && WS_OB + (size_t)M * D * 2 <= WS_END, "d_ws map");
constexpr int CW_BAR = 4096;
constexpr int CW_QUEUE = 16384;
constexpr int RING_OFF = 0, RING_BYTES = 131072;
constexpr int LDSCTL_OFF = RING_BYTES + 8192, MISC_OFF = LDSCTL_OFF + 320;
constexpr int LDS_BYTES = 147456;
static_assert(MISC_OFF + 128 <= LDS_BYTES, "LDS map");
#define GAS __attribute__((address_space(1)))
#define LAS __attribute__((address_space(3)))
typedef unsigned short bf16;
typedef unsigned v4u __attribute__((ext_vector_type(4)));
typedef float f32x4 __attribute__((ext_vector_type(4)));
typedef short bf16x8 __attribute__((ext_vector_type(8)));
typedef GAS unsigned gu32;
typedef GAS unsigned long long gu64;
#define RLX_AGENT __ATOMIC_RELAXED, __HIP_MEMORY_SCOPE_AGENT
#define LDS_WAIT() asm volatile("s_waitcnt lgkmcnt(0)" ::: "memory")
#define VM_WAIT() asm volatile("s_waitcnt vmcnt(0)" ::: "memory")
__device__ __forceinline__ unsigned long long rt() { return __builtin_amdgcn_s_memrealtime(); }
__device__ __forceinline__ unsigned f2bf(float f) { unsigned u = __builtin_bit_cast(unsigned, f); return (u + 0x7fffu + ((u >> 16) & 1u)) >> 16; }
__device__ __forceinline__ unsigned pk2(float lo, float hi) { return f2bf(lo) | (f2bf(hi) << 16); }
#define XB_TMO      128
#define XB_XCNT(j)  (256  + 64 * (j))
#define XB_XSUB(j)  (1280 + 64 * (j))
#define XB_XGEN(j)  (2304 + 64 * (j))
#define XB_TOP      3328
#define XB_TOPGEN   3392
#define XCD_BAR_WORDS 3456
#define XB_SPIN_CAP (1u << 18)

__device__ __forceinline__ unsigned xb_ld(unsigned* p)              { return __hip_atomic_load(p, __ATOMIC_RELAXED, __HIP_MEMORY_SCOPE_AGENT); }
__device__ __forceinline__ unsigned xb_add(unsigned* p, unsigned v) { return __hip_atomic_fetch_add(p, v, __ATOMIC_RELAXED, __HIP_MEMORY_SCOPE_AGENT); }
__device__ __forceinline__ unsigned xb_xcc_id() { return (unsigned)__builtin_amdgcn_s_getreg((3 << 11) | 20) & 0xFu; }
#define XB_SPIN(cond, bar) do { unsigned _sp = 0; while (cond) { __builtin_amdgcn_s_sleep(1); \
    if ((++_sp & 255u) == 0u) { if (xb_ld(&(bar)[XB_TMO])) break; if (_sp > XB_SPIN_CAP) { atomicAdd(&(bar)[XB_TMO], 1u); break; } } } } while (0)

struct XcdBarrier {
    unsigned* bar; unsigned x;
    volatile LAS unsigned* st;
};

__device__ __forceinline__ XcdBarrier xcd_barrier_post(unsigned* bar, volatile LAS unsigned* st) {
    XcdBarrier b; b.bar = bar; b.x = xb_xcc_id(); b.st = st;
    if (threadIdx.x == 0) (void)xb_add(&bar[XB_XCNT(b.x)], 1u);
    return b;
}
__device__ __forceinline__ void xcd_barrier_complete(unsigned* bar, unsigned x, unsigned& nloc, unsigned& nx) {
    const unsigned G = gridDim.x * gridDim.y * gridDim.z;
    unsigned sum, cnt, mine, sp = 0u;
    for (;;) {
        sum = 0u; cnt = 0u; mine = 0u;
#pragma unroll
        for (unsigned j = 0; j < 16; ++j) { const unsigned c = xb_ld(&bar[XB_XCNT(j)]); sum += c; cnt += (c > 0u) ? 1u : 0u; mine = (j == x) ? c : mine; }
        if (sum == G) break;
        __builtin_amdgcn_s_sleep(1);
        if ((++sp & 255u) == 0u) { if (xb_ld(&bar[XB_TMO])) break; if (sp > XB_SPIN_CAP) { atomicAdd(&bar[XB_TMO], 1u); break; } }
    }
    nloc = mine > 0u ? mine : 1u; nx = cnt > 0u ? cnt : 1u;
}

__device__ __forceinline__ void xcd_barrier(const XcdBarrier& b) {
    asm volatile("s_waitcnt vmcnt(0)" ::: "memory");
    __syncthreads();
    if (threadIdx.x == 0) {
        unsigned* bar = b.bar;
        __builtin_amdgcn_s_waitcnt(0);
        unsigned nloc = b.st[0], nx = b.st[1];
        if (nloc == 0u) { xcd_barrier_complete(bar, b.x, nloc, nx); b.st[0] = nloc; b.st[1] = nx; }
        const unsigned old = xb_add(&bar[XB_XSUB(b.x)], 1u);
        const unsigned gen = old / nloc;
        if (old + 1u == (gen + 1u) * nloc) {
            __builtin_amdgcn_fence(__ATOMIC_RELEASE, "agent");
            asm volatile("s_waitcnt vmcnt(0)" ::: "memory");
            const unsigned og = xb_add(&bar[XB_TOP], 1u);
            const unsigned tg = og / nx;
            if (og + 1u == (tg + 1u) * nx) xb_add(&bar[XB_TOPGEN], 1u);
            else XB_SPIN(xb_ld(&bar[XB_TOPGEN]) == tg, bar);
            __builtin_amdgcn_fence(__ATOMIC_ACQUIRE, "agent");
            xb_add(&bar[XB_XGEN(b.x)], 1u);
            asm volatile("s_waitcnt vmcnt(0)" ::: "memory");
        } else {
            XB_SPIN(xb_ld(&bar[XB_XGEN(b.x)]) == gen, bar);
            __builtin_amdgcn_fence(__ATOMIC_ACQUIRE, "agent");
            asm volatile("s_waitcnt vmcnt(0)" ::: "memory");
        }
    }
    __syncthreads();
}
struct Frame {
    LAS unsigned char* lds;
    volatile LAS unsigned* MISC;
    gu32* ctl;
    int tid, lane, wave;
    int vcu, G;
    const float* x; float* out;
    const float *g1w, *u1w, *d1w, *ln1g, *ln1b, *win, *wout, *ln2g, *ln2b, *g2w, *u2w, *d2w, *ln3g, *ln3b;
    bf16 *W1T, *W2T, *WINT, *WOT, *W3T, *W4T;
    bf16 *XB, *HB, *QB, *KB, *VB, *OB;
    float *Y, *KS;
};

__device__ __forceinline__ float wave_sum(float v) {
#pragma unroll
    for (int o = 1; o < 64; o <<= 1) v += __shfl_xor(v, o);
    return v;
}
__device__ __forceinline__ int dest_row(int kind, int n0) {
    if (kind == 0) return n0;
    if (kind == 1) return 256 * (n0 >> 7) + (n0 & 127);
    if (kind == 2) return 256 * (n0 >> 7) + 128 + (n0 & 127);
    if (n0 < WIDTH_A) return n0;
    if (n0 < 2 * WIDTH_A) return D + (n0 - WIDTH_A);
    if (n0 < 3 * WIDTH_A) return 2 * D + (n0 - 2 * WIDTH_A);
    if (n0 < 3 * WIDTH_A + WIDTH_B) return WIDTH_A + (n0 - 3 * WIDTH_A);
    if (n0 < 3 * WIDTH_A + 2 * WIDTH_B) return D + WIDTH_A + (n0 - 3 * WIDTH_A - WIDTH_B);
    return 2 * D + WIDTH_A + (n0 - 3 * WIDTH_A - 2 * WIDTH_B);
}
__device__ __forceinline__ void p0_transpose_item(const float* W, int K, int N, bf16* WT, int kind, LAS float* scr, int item, int lane) {
    const int nblk = N / 32, kb = item / nblk, nb = item % nblk, k0 = 64 * kb, n0 = 32 * nb;
    const int drow0 = dest_row(kind, n0);
#pragma unroll 8
    for (int i = 0; i < 32; ++i) { const int kk = 2 * i + (lane >> 5); scr[kk * 33 + (lane & 31)] = W[(size_t)(k0 + kk) * N + n0 + (lane & 31)]; }
    LDS_WAIT(); asm volatile("" ::: "memory");
    const int c = lane & 7;
#pragma unroll
    for (int j = 0; j < 4; ++j) { const int n = (lane >> 3) + 8 * j; const LAS float* s = scr + (8 * c) * 33 + n;
        v4u o; o.x = pk2(s[0 * 33], s[1 * 33]); o.y = pk2(s[2 * 33], s[3 * 33]); o.z = pk2(s[4 * 33], s[5 * 33]); o.w = pk2(s[6 * 33], s[7 * 33]);
        *(GAS v4u*)(WT + (size_t)(drow0 + n) * K + k0 + 8 * c) = o; }
    LDS_WAIT(); asm volatile("" ::: "memory");
}
__device__ __forceinline__ void cvt_row_to_bf16(int lane, const float* xrow, bf16* orow) {
    const GAS f32x4* xr = (const GAS f32x4*)xrow + lane;
    f32x4 v[4];
#pragma unroll
    for (int j = 0; j < 4; ++j) v[j] = xr[64 * j];
    GAS unsigned long long* o8 = (GAS unsigned long long*)orow + lane;
#pragma unroll
    for (int j = 0; j < 4; ++j) o8[64 * j] = (unsigned long long)pk2(v[j].x, v[j].y) | ((unsigned long long)pk2(v[j].z, v[j].w) << 32);
}
__device__ __forceinline__ void ln_row(int lane, const float* xrow, const float* g, const float* b, bf16* ob, float* of) {
    const GAS f32x4* xr = (const GAS f32x4*)xrow + lane;
    f32x4 v[4]; float s = 0.f;
#pragma unroll
    for (int j = 0; j < 4; ++j) { v[j] = xr[64 * j]; s += (v[j].x + v[j].y) + (v[j].z + v[j].w); }
    const float mean = wave_sum(s) * (1.f / D); float s2 = 0.f;
#pragma unroll
    for (int j = 0; j < 4; ++j) { v[j] = v[j] - mean; s2 += (v[j].x * v[j].x + v[j].y * v[j].y) + (v[j].z * v[j].z + v[j].w * v[j].w); }
    const float rstd = 1.f / sqrtf(wave_sum(s2) * (1.f / D) + LN_EPS);
#pragma unroll
    for (int j = 0; j < 4; ++j) { const f32x4 gg = ((const GAS f32x4*)g)[lane + 64 * j], bb = ((const GAS f32x4*)b)[lane + 64 * j]; v[j] = v[j] * rstd * gg + bb; }
    if (ob) { GAS unsigned long long* o8 = (GAS unsigned long long*)ob + lane;
#pragma unroll
        for (int j = 0; j < 4; ++j) o8[64 * j] = (unsigned long long)pk2(v[j].x, v[j].y) | ((unsigned long long)pk2(v[j].z, v[j].w) << 32); }
    if (of) { GAS f32x4* o4 = (GAS f32x4*)of + lane;
#pragma unroll
        for (int j = 0; j < 4; ++j) o4[64 * j] = v[j]; }
}
__device__ __forceinline__ void ln_phase(Frame& F, const float* src, const float* g, const float* b, bf16* ob, float* of) {
    const int gw = F.vcu * NWAVES + F.wave, NGW = F.G * NWAVES;
    for (int m = gw; m < M; m += NGW) ln_row(F.lane, src + (size_t)m * D, g, b, ob ? ob + (size_t)m * D : nullptr, of ? of + (size_t)m * D : nullptr);
}
__device__ __forceinline__ void p0_prologue(Frame& F) {
    LAS float* scr = (LAS float*)(F.lds + RING_OFF + F.wave * 16384);
    const int gw = F.vcu * NWAVES + F.wave, NGW = F.G * NWAVES;
    constexpr int I_GU = (D / 64) * (FF / 32), I_DN = (FF / 64) * (D / 32), I_IN = (D / 64) * (NQKV / 32), I_OUT = (D / 64) * (D / 32);
    constexpr int NITEMS = 4 * I_GU + 2 * I_DN + I_IN + I_OUT;
    for (int it = gw; it < NITEMS; it += NGW) {
        int r = it;
        if (r < I_GU) { p0_transpose_item(F.g1w, D, FF, F.W1T, 1, scr, r, F.lane); continue; } r -= I_GU;
        if (r < I_GU) { p0_transpose_item(F.u1w, D, FF, F.W1T, 2, scr, r, F.lane); continue; } r -= I_GU;
        if (r < I_DN) { p0_transpose_item(F.d1w, FF, D, F.W2T, 0, scr, r, F.lane); continue; } r -= I_DN;
        if (r < I_IN) { p0_transpose_item(F.win, D, NQKV, F.WINT, 3, scr, r, F.lane); continue; } r -= I_IN;
        if (r < I_OUT) { p0_transpose_item(F.wout, D, D, F.WOT, 0, scr, r, F.lane); continue; } r -= I_OUT;
        if (r < I_GU) { p0_transpose_item(F.g2w, D, FF, F.W3T, 1, scr, r, F.lane); continue; } r -= I_GU;
        if (r < I_GU) { p0_transpose_item(F.u2w, D, FF, F.W3T, 2, scr, r, F.lane); continue; } r -= I_GU;
        p0_transpose_item(F.d2w, FF, D, F.W4T, 0, scr, r, F.lane);
    }
    for (int m = gw; m < M; m += NGW) cvt_row_to_bf16(F.lane, F.x + (size_t)m * D, F.XB + (size_t)m * D);
}
__device__ __forceinline__ void ld16bf(const bf16* p, float (&o)[16]) {
    const v4u a = *(const GAS v4u*)p, b = *((const GAS v4u*)p + 1);
    const unsigned w[8] = {a.x, a.y, a.z, a.w, b.x, b.y, b.z, b.w};
#pragma unroll
    for (int i = 0; i < 8; ++i) { o[2 * i] = __uint_as_float(w[i] << 16); o[2 * i + 1] = __uint_as_float(w[i] & 0xffff0000u); }
}
__device__ __forceinline__ void as_visit(const bf16* Kp, const bf16* Vp, size_t roff, bool valid, float bias, const float (&q)[16], float (&o)[16], float& mx, float& l) {
    float k[16]; ld16bf(Kp + roff, k);
    float s = 0.f;
#pragma unroll
    for (int i = 0; i < 16; ++i) s += q[i] * k[i];
    s += __shfl_xor(s, 1); s += __shfl_xor(s, 2);
    s = valid ? s + bias : -INFINITY;
    const float mn = fmaxf(mx, s), f = exp2f(mx - mn), p = exp2f(s - mn);
    float v[16]; ld16bf(Vp + roff, v);
    l = l * f + p;
#pragma unroll
    for (int i = 0; i < 16; ++i) o[i] = o[i] * f + p * v[i];
    mx = mn;
}
__device__ __forceinline__ void attn_slow(Frame& F) {
    const int gw = F.vcu * NWAVES + F.wave, NGW = F.G * NWAVES;
    const int sub = F.lane & 3, ql = F.lane >> 2;
    constexpr int TG = M / 16;
    for (int item = gw; item < 16 * TG; item += NGW) {
        const int head = item / TG, tg = item % TG;
        const int token = tg * 16 + ql, b = token / SEQ, t = token % SEQ;
        const int coff = head * 64 + sub * 16;
        float q[16]; ld16bf(F.QB + (size_t)token * D + coff, q);
        float mx = -1e30f, l = 0.f, o[16];
#pragma unroll
        for (int i = 0; i < 16; ++i) o[i] = 0.f;
        const size_t bbase = (size_t)b * SEQ * D + coff;
        if (head < NHA) {
            const int idx = head + head / 3;
            const float sl2 = exp2f(-0.5f * (float)(idx + 1)) * 1.4426950408889634f;
            for (int br = 0; br < 3; ++br) { const int d = (br == 0) ? 1 : (br == 1 ? 4 : 16);
                for (int j = 0; j <= 128; ++j) { const int kt = t - j * d; const bool valid = kt >= 0;
                    as_visit(F.KB, F.VB, bbase + (size_t)(valid ? kt : 0) * D, valid, -sl2 * (float)(j * d), q, o, mx, l); } }
        } else {
            const int hb = head - NHA;
            const float sl2 = exp2f(-2.0f * (float)(hb + 1)) * 1.4426950408889634f;
            const int n = t >> 8, a = t & 255;
            float g[8]; bool sel[8];
#pragma unroll
            for (int m = 0; m < 8; ++m) { g[m] = -INFINITY;
                if (m < n) { const float* kp = F.KS + (size_t)(b * 8 + m) * 256 + hb * 64 + sub * 16; float s = 0.f;
#pragma unroll
                    for (int i = 0; i < 16; ++i) s += q[i] * kp[i];
                    s += __shfl_xor(s, 1); s += __shfl_xor(s, 2); g[m] = s; } }
#pragma unroll
            for (int m = 0; m < 8; ++m) { int better = 0;
#pragma unroll
                for (int m2 = 0; m2 < 8; ++m2) if (m2 != m && m2 < n) better += (g[m2] > g[m] || (g[m2] == g[m] && m2 < m)) ? 1 : 0;
                sel[m] = (m < n) && (better < 3); }
            for (int kk = 0; kk < 256; ++kk) as_visit(F.KB, F.VB, bbase + (size_t)(n * 256 + kk) * D, kk <= a, -sl2 * (float)(a - kk), q, o, mx, l);
#pragma unroll
            for (int m = 0; m < 8; ++m) if (m < n)
                for (int kk = 0; kk < 256; ++kk) as_visit(F.KB, F.VB, bbase + (size_t)(m * 256 + kk) * D, sel[m], -sl2 * (float)(t - (m * 256 + kk)), q, o, mx, l);
        }
        const float rl = 1.f / l;
        v4u w0, w1;
        w0.x = pk2(o[0] * rl, o[1] * rl); w0.y = pk2(o[2] * rl, o[3] * rl); w0.z = pk2(o[4] * rl, o[5] * rl); w0.w = pk2(o[6] * rl, o[7] * rl);
        w1.x = pk2(o[8] * rl, o[9] * rl); w1.y = pk2(o[10] * rl, o[11] * rl); w1.z = pk2(o[12] * rl, o[13] * rl); w1.w = pk2(o[14] * rl, o[15] * rl);
        GAS v4u* op = (GAS v4u*)(F.OB + (size_t)token * D + coff); op[0] = w0; op[1] = w1;
    }
}
struct Args { const float* in[15]; float* out; unsigned char* ws; };
__global__ void __launch_bounds__(NWAVES * 64, 2) fwd_kernel(Args args) {
    extern __shared__ __attribute__((aligned(16))) unsigned char lds[];
    Frame F;
    F.lds = (LAS unsigned char*)lds;
    F.MISC = (volatile LAS unsigned*)(F.lds + MISC_OFF);
    F.tid = threadIdx.x; F.lane = F.tid & 63; F.wave = __builtin_amdgcn_readfirstlane(F.tid >> 6);
    F.G = gridDim.x; { const int bx = blockIdx.x; F.vcu = (F.G % 8 == 0) ? (bx % 8) * (F.G / 8) + bx / 8 : bx; }
    unsigned char* ws = args.ws;
    F.ctl = (gu32*)(ws + WS_CTL);
    F.x = args.in[0]; F.g1w = args.in[1]; F.u1w = args.in[2]; F.d1w = args.in[3]; F.ln1g = args.in[4]; F.ln1b = args.in[5]; F.win = args.in[6]; F.wout = args.in[7];
    F.ln2g = args.in[8]; F.ln2b = args.in[9]; F.g2w = args.in[10]; F.u2w = args.in[11]; F.d2w = args.in[12]; F.ln3g = args.in[13]; F.ln3b = args.in[14]; F.out = args.out;
    F.W1T = (bf16*)(ws + WS_W1T); F.W2T = (bf16*)(ws + WS_W2T); F.WINT = (bf16*)(ws + WS_WINT); F.WOT = (bf16*)(ws + WS_WOT); F.W3T = (bf16*)(ws + WS_W3T); F.W4T = (bf16*)(ws + WS_W4T);
    F.XB = (bf16*)(ws + WS_XB); F.HB = (bf16*)(ws + WS_R1); F.QB = (bf16*)(ws + WS_R1); F.KB = (bf16*)(ws + WS_R1 + (size_t)M * D * 2); F.VB = (bf16*)(ws + WS_R1 + (size_t)2 * M * D * 2);
    F.OB = (bf16*)(ws + WS_OB); F.Y = (float*)(ws + WS_Y); F.KS = (float*)(ws + WS_KS);
    for (int u = F.tid; u < (LDS_BYTES - LDSCTL_OFF) / 4; u += NWAVES * 64) ((LAS unsigned*)(F.lds + LDSCTL_OFF))[u] = 0u;
    __syncthreads();
    XcdBarrier bar = xcd_barrier_post((unsigned*)(F.ctl + CW_BAR), F.MISC + 8);

    p0_prologue(F);
    xcd_barrier(bar);
    { pg8::Gemm g{F.XB, F.W1T, M, NGU, D}; pg8::StaticOrder S; S.init(M, NGU, F.G, (int)blockIdx.x);
      pg8::EpiSwiGLU E{F.HB, FF};
      pg8::gemm_phase<pg8::EpiSwiGLU, pg8::StaticOrder, PG8_ALIGN, PG8_SP2>(F.lds + RING_OFF, g, S, E); }
    xcd_barrier(bar);
    { pg8::Gemm g{F.HB, F.W2T, M, D, FF}; pg8::StaticOrder S; S.init(M, D, F.G, (int)blockIdx.x);
      pg8::EpiResF32 E{F.x, F.Y, D, ALPHA, 0.5f};
      pg8::gemm_phase<pg8::EpiResF32, pg8::StaticOrder, PG8_ALIGN, PG8_SP2>(F.lds + RING_OFF, g, S, E); }
    xcd_barrier(bar);
    ln_phase(F, F.Y, F.ln1g, F.ln1b, F.XB, F.Y);
    xcd_barrier(bar);
    { pg8::Gemm g{F.XB, F.WINT, M, NQKV, D}; pg8::StaticOrder S; S.init(M, NQKV, F.G, (int)blockIdx.x);
      pg8::EpiQKV E{F.QB, (size_t)M * D, QSCALE, F.KS};
      pg8::gemm_phase<pg8::EpiQKV, pg8::StaticOrder, PG8_ALIGN, PG8_SP2>(F.lds + RING_OFF, g, S, E); }
    xcd_barrier(bar);
    attn_slow(F);
    xcd_barrier(bar);
    { pg8::Gemm g{F.OB, F.WOT, M, D, D}; pg8::StaticOrder S; S.init(M, D, F.G, (int)blockIdx.x);
      pg8::EpiResF32 E{F.Y, F.Y, D, ALPHA, 1.0f};
      pg8::gemm_phase<pg8::EpiResF32, pg8::StaticOrder, PG8_ALIGN, PG8_SP2>(F.lds + RING_OFF, g, S, E); }
    xcd_barrier(bar);
    ln_phase(F, F.Y, F.ln2g, F.ln2b, F.XB, F.Y);
    xcd_barrier(bar);
    { pg8::Gemm g{F.XB, F.W3T, M, NGU, D}; pg8::StaticOrder S; S.init(M, NGU, F.G, (int)blockIdx.x);
      pg8::EpiSwiGLU E{F.HB, FF};
      pg8::gemm_phase<pg8::EpiSwiGLU, pg8::StaticOrder, PG8_ALIGN, PG8_SP2>(F.lds + RING_OFF, g, S, E); }
    xcd_barrier(bar);
    { pg8::Gemm g{F.HB, F.W4T, M, D, FF}; pg8::StaticOrder S; S.init(M, D, F.G, (int)blockIdx.x);
      pg8::EpiResF32 E{F.Y, F.Y, D, ALPHA, 0.5f};
      pg8::gemm_phase<pg8::EpiResF32, pg8::StaticOrder, PG8_ALIGN, PG8_SP2>(F.lds + RING_OFF, g, S, E); }
    xcd_barrier(bar);
    ln_phase(F, F.Y, F.ln3g, F.ln3b, nullptr, F.out);
}

extern "C" void kernel_launch(void* const* d_in, const int* in_sizes, int n_in, void* d_out, int out_size, void* d_ws, size_t ws_size, hipStream_t stream) {
    static int grid = 0;
    if (grid == 0) {
        if (n_in != 15 || in_sizes[0] != M * D || out_size != M * D || ws_size < WS_END) { fprintf(stderr, "kernel_launch: shape/workspace mismatch (n_in %d, in0 %d, out %d, ws %zu)\n", n_in, n_in > 0 ? in_sizes[0] : -1, out_size, ws_size); grid = -1; return; }
        int dev = 0, cus = 0, per_cu = 0;
        if (hipGetDevice(&dev) != hipSuccess || hipDeviceGetAttribute(&cus, hipDeviceAttributeMultiprocessorCount, dev) != hipSuccess) { grid = -1; return; }
        if (hipFuncSetAttribute((const void*)fwd_kernel, hipFuncAttributeMaxDynamicSharedMemorySize, LDS_BYTES) != hipSuccess) { fprintf(stderr, "kernel_launch: hipFuncSetAttribute failed\n"); grid = -1; return; }
        if (hipOccupancyMaxActiveBlocksPerMultiprocessor(&per_cu, (const void*)fwd_kernel, NWAVES * 64, LDS_BYTES) != hipSuccess || per_cu < 1) { fprintf(stderr, "kernel_launch: occupancy query reports %d\n", per_cu); }
        (void)hipGetLastError();
        grid = cus;
    }
    if (grid < 0) return;
    if (hipMemsetAsync((char*)d_ws + WS_CTL, 0, CTL_ZERO_BYTES, stream) != hipSuccess) return;
    Args a{};
    for (int i = 0; i < 15; ++i) a.in[i] = (const float*)d_in[i];
    a.out = (float*)d_out; a.ws = (unsigned char*)d_ws;
    hipLaunchKernelGGL(fwd_kernel, dim3(grid), dim3(NWAVES * 64), LDS_BYTES, stream, a);
}
```

```cpp
#define XCD_SKEW 1u
#include <hip/hip_runtime.h>
#include <cstdio>
#include <cstdint>
#include <cmath>
namespace pg8 {
#define PG8_LAS __attribute__((address_space(3)))
typedef unsigned short bf16_t;
typedef short bf16x8 __attribute__((ext_vector_type(8)));
typedef float f32x4 __attribute__((ext_vector_type(4)));
typedef unsigned u32x4 __attribute__((ext_vector_type(4)));
constexpr int BM = 256, BK = 64, HALF = 128, HTB = HALF * BK * 2  , STAGE_BYTES = 8 * HTB, NXCD = 8, WGM = 8;

__host__ __device__ __forceinline__ int lds_byte(int r, int c) { const int st = (r >> 4) * 2 + (c >> 5), rr = r & 15, cc = c & 31, ob = rr * 64 + cc * 2; return st * 1024 + (ob ^ (((ob >> 9) & 1) << 5)); }
__host__ __device__ __forceinline__ void stage_rc(int b, int& R, int& C) { const int st = b / 1024, sb = b % 1024, swz = sb ^ (((sb >> 9) & 1) << 5); R = (st >> 1) * 16 + swz / 64; C = (st & 1) * 32 + (swz % 64) / 2; }
__host__ __device__ __forceinline__ int perm32(int rho) { const int n = rho >> 4, i = rho & 15; return 8 * (i >> 2) + 4 * n + (i & 3); }

struct Unit { int pm, pn; };
struct Gemm { const bf16_t* A; const bf16_t* Bt; int M, N, K; };

struct StaticOrder {
    int nM, nN, nwg, G, c;
    __host__ __device__ void init(int M, int N, int G_, int c_) { nM = M / BM; nN = N / BM; nwg = nM * nN; G = G_; c = c_; }
    __host__ __device__ __forceinline__ bool next(int i, Unit& u) const {
        const long L = (long)i * G + c; if (L >= nwg) return false;
        int wgid = (int)L; { const int q = nwg / NXCD, r = nwg % NXCD, xcd = wgid % NXCD, off = wgid / NXCD; wgid = (xcd < r ? xcd * (q + 1) : r * (q + 1) + (xcd - r) * q) + off; }
        const int nig = WGM * nN, gid = wgid / nig, fm = gid * WGM, gsz = (nM - fm) < WGM ? (nM - fm) : WGM;
        u.pm = fm + ((wgid % nig) % gsz); u.pn = (wgid % nig) / gsz; return true;
    }
    __device__ __forceinline__ void a_ready(const Unit&) const {}
    __device__ __forceinline__ void done(const Unit&) const {}
};

__device__ __forceinline__ unsigned cvt_pk_bf16(float lo, float hi) { unsigned r; asm volatile("v_cvt_pk_bf16_f32 %0, %1, %2" : "=v"(r) : "v"(lo), "v"(hi)); return r; }
typedef float f32x2 __attribute__((ext_vector_type(2)));
typedef float f32x2v __attribute__((ext_vector_type(2)));
typedef _Float16 h16x2 __attribute__((ext_vector_type(2)));
__device__ __forceinline__ unsigned cvt_pk_f16(float lo, float hi) { f32x2v v = {lo, hi}; return __builtin_bit_cast(unsigned, __builtin_convertvector(v, h16x2)); }
__device__ __forceinline__ f32x2v unpk_f16(unsigned w) { const h16x2 h = __builtin_bit_cast(h16x2, w); return (f32x2v){(float)h[0], (float)h[1]}; }
struct LnFold { PG8_LAS const f32x2v* RS; const float* cs; const float* bw; };

template <bool FOLD> struct EpiSwiGLU {
    static constexpr bool PERM = true, AFTER_DRAIN = false; static constexpr int NVMEM = 8;
    bf16_t* H; int ldh; LnFold lf;
    __device__ __forceinline__ static float silu_mul(float g, float u) { const float e = __builtin_amdgcn_exp2f(g * -1.4426950408889634f); return g * __builtin_amdgcn_rcpf(1.0f + e) * u; }
    __device__ __forceinline__ void operator()(const f32x4 (&acc)[2][2][4][2], const Unit& u, int wr_, int wc_, int fr_, int fq_, PG8_LAS unsigned char*, int tid) const {
        int t_ = tid; asm volatile("" : "+v"(t_));
        const int lane_ = t_ & 63, wid_ = __builtin_amdgcn_readfirstlane(t_ >> 6), wr = wid_ >> 2, wc = wid_ & 3, fr = lane_ & 15, fq = lane_ >> 4; (void)wr_; (void)wc_; (void)fr_; (void)fq_;
        const int row0 = u.pm * BM + wr * 64 + fr, col0 = u.pn * HALF + wc * 32 + 8 * fq, bcol0 = u.pn * BM + wc * 32 + 8 * fq;
        f32x4 cs[2][2], bw[2][2];
        if (FOLD) {
#pragma unroll
            for (int bj = 0; bj < 2; ++bj)
#pragma unroll
                for (int n = 0; n < 2; ++n) { cs[bj][n] = *(const f32x4*)(lf.cs + bcol0 + bj * HALF + 4 * n); bw[bj][n] = *(const f32x4*)(lf.bw + bcol0 + bj * HALF + 4 * n); }
        }
#pragma unroll
        for (int ai = 0; ai < 2; ++ai)
#pragma unroll
            for (int m = 0; m < 4; ++m) { const int row = row0 + ai * HALF + m * 16; bf16_t* rowp = H + (size_t)row * ldh + col0;
                f32x4 g0 = acc[ai][0][m][0], g1 = acc[ai][0][m][1], u0 = acc[ai][1][m][0], u1 = acc[ai][1][m][1];
                if (FOLD) { const f32x2v rs = lf.RS[((u.pm >> 3) & 3) * BM + (row & (BM - 1))];
                    g0 = (g0 - cs[0][0] * rs.x) * rs.y + bw[0][0]; g1 = (g1 - cs[0][1] * rs.x) * rs.y + bw[0][1];
                    u0 = (u0 - cs[1][0] * rs.x) * rs.y + bw[1][0]; u1 = (u1 - cs[1][1] * rs.x) * rs.y + bw[1][1]; }
                u32x4 w; w.x = cvt_pk_bf16(silu_mul(g0[0], u0[0]), silu_mul(g0[1], u0[1])); w.y = cvt_pk_bf16(silu_mul(g0[2], u0[2]), silu_mul(g0[3], u0[3]));
                w.z = cvt_pk_bf16(silu_mul(g1[0], u1[0]), silu_mul(g1[1], u1[1])); w.w = cvt_pk_bf16(silu_mul(g1[2], u1[2]), silu_mul(g1[3], u1[3]));
                *(u32x4*)rowp = w; }
    }
};
template <bool RES_LN> struct EpiRes {
    static constexpr bool PERM = true, AFTER_DRAIN = false; static constexpr int NVMEM = 16;
    const float* X; bf16_t* YB; unsigned short* YH; f32x2v* PS; PG8_LAS const f32x2v* RS  ; const float* g; const float* b; float alpha, beta;
    __device__ __forceinline__ void operator()(const f32x4 (&acc)[2][2][4][2], const Unit& u, int wr_, int wc_, int fr_, int fq_, PG8_LAS unsigned char* xlds, int tid) const {
        int t_ = tid; asm volatile("" : "+v"(t_));
        const int lane_ = t_ & 63, wid_ = __builtin_amdgcn_readfirstlane(t_ >> 6), wr = wid_ >> 2, wc = wid_ & 3, fr = lane_ & 15, fq = lane_ >> 4; (void)wr_; (void)wc_; (void)fr_; (void)fq_;
        const int row0 = u.pm * BM + wr * 64 + fr, col0 = u.pn * BM + wc * 32 + 8 * fq;
        f32x4 gg[2][2], bb[2][2];
        if (RES_LN) {
#pragma unroll
            for (int bj = 0; bj < 2; ++bj)
#pragma unroll
                for (int n = 0; n < 2; ++n) { gg[bj][n] = *(const f32x4*)(g + col0 + bj * HALF + 4 * n); bb[bj][n] = *(const f32x4*)(b + col0 + bj * HALF + 4 * n); }
        }
        PG8_LAS f32x2v* P = (PG8_LAS f32x2v*)xlds;
#pragma unroll
        for (int ai = 0; ai < 2; ++ai)
#pragma unroll
            for (int m = 0; m < 4; ++m) { const int row = row0 + ai * HALF + m * 16; const size_t off = (size_t)row * 1024 + col0;
                f32x4 r[2][2];
                if (RES_LN) { const f32x2v rs = RS[((u.pm >> 3) & 3) * BM + (row & (BM - 1))];
#pragma unroll
                    for (int bj = 0; bj < 2; ++bj) { const u32x4 hw = *(const u32x4*)(YH + off + bj * HALF);
                        const f32x2v a0 = unpk_f16(hw.x), a1 = unpk_f16(hw.y), a2 = unpk_f16(hw.z), a3 = unpk_f16(hw.w);
                        r[bj][0] = ((f32x4){a0.x, a0.y, a1.x, a1.y} - rs.x) * rs.y * gg[bj][0] + bb[bj][0];
                        r[bj][1] = ((f32x4){a2.x, a2.y, a3.x, a3.y} - rs.x) * rs.y * gg[bj][1] + bb[bj][1]; }
                } else {
#pragma unroll
                    for (int bj = 0; bj < 2; ++bj)
#pragma unroll
                        for (int n = 0; n < 2; ++n) r[bj][n] = *(const f32x4*)(X + off + bj * HALF + 4 * n);
                }
                float s1 = 0.f, s2 = 0.f;
#pragma unroll
                for (int bj = 0; bj < 2; ++bj) { const f32x4 v0 = r[bj][0] * alpha + acc[ai][bj][m][0] * beta, v1 = r[bj][1] * alpha + acc[ai][bj][m][1] * beta;
                    s1 += (v0[0] + v0[1]) + (v0[2] + v0[3]) + (v1[0] + v1[1]) + (v1[2] + v1[3]);
                    s2 += (v0[0] * v0[0] + v0[1] * v0[1]) + (v0[2] * v0[2] + v0[3] * v0[3]) + (v1[0] * v1[0] + v1[1] * v1[1]) + (v1[2] * v1[2] + v1[3] * v1[3]);
                    u32x4 w; w.x = cvt_pk_f16(v0[0], v0[1]); w.y = cvt_pk_f16(v0[2], v0[3]); w.z = cvt_pk_f16(v1[0], v1[1]); w.w = cvt_pk_f16(v1[2], v1[3]);
                    *(u32x4*)(YH + off + bj * HALF) = w;
                    if (YB) { u32x4 wb; wb.x = cvt_pk_bf16(v0[0], v0[1]); wb.y = cvt_pk_bf16(v0[2], v0[3]); wb.z = cvt_pk_bf16(v1[0], v1[1]); wb.w = cvt_pk_bf16(v1[2], v1[3]);
                        *(u32x4*)(YB + off + bj * HALF) = wb; } }
                s1 += __shfl_xor(s1, 16); s1 += __shfl_xor(s1, 32); s2 += __shfl_xor(s2, 16); s2 += __shfl_xor(s2, 32);
                if (fq == 0) P[(ai * HALF + wr * 64 + m * 16 + fr) * 4 + wc] = (f32x2v){s1, s2};
                asm volatile("" ::: "memory"); }
        asm volatile("s_waitcnt lgkmcnt(0)" ::: "memory"); __builtin_amdgcn_s_barrier(); asm volatile("" ::: "memory");
        if (tid < 256) { const f32x2v a = P[tid * 4 + 0], b2 = P[tid * 4 + 1], c = P[tid * 4 + 2], d = P[tid * 4 + 3];
            PS[(size_t)(u.pm * BM + tid) * 4 + u.pn] = (f32x2v){(a.x + b2.x) + (c.x + d.x), (a.y + b2.y) + (c.y + d.y)}; }
    }
};
struct EpiQKV {
    static constexpr bool PERM = true, AFTER_DRAIN = false; static constexpr int NVMEM = 16;
    bf16_t* O; bf16_t* KV; size_t split_stride; float scale0; float* ksum; LnFold lf;
    __device__ __forceinline__ void operator()(const f32x4 (&acc)[2][2][4][2], const Unit& u, int wr_, int wc_, int fr_, int fq_, PG8_LAS unsigned char*, int tid) const {
        int t_ = tid; asm volatile("" : "+v"(t_));
        const int lane_ = t_ & 63, wid_ = __builtin_amdgcn_readfirstlane(t_ >> 6), wr = wid_ >> 2, wc = wid_ & 3, fr = lane_ & 15, fq = lane_ >> 4; (void)wr_; (void)wc_; (void)fr_; (void)fq_;
        const int row0 = u.pm * BM + wr * 64 + fr; const int t = u.pn >> 2; const int colt = (u.pn & 3) * BM;
        bf16_t* base = (t == 0) ? O : KV + (size_t)(t - 1) * split_stride; const float sc = (t == 0) ? scale0 : 1.f;
        const int col0 = colt + wc * 32 + 8 * fq, bcol0 = u.pn * BM + wc * 32 + 8 * fq;
        f32x4 cs[2][2], bw[2][2];
#pragma unroll
        for (int bj = 0; bj < 2; ++bj)
#pragma unroll
            for (int n = 0; n < 2; ++n) { cs[bj][n] = *(const f32x4*)(lf.cs + bcol0 + bj * HALF + 4 * n); bw[bj][n] = *(const f32x4*)(lf.bw + bcol0 + bj * HALF + 4 * n); }
        f32x4 ks[2][2];
#pragma unroll
        for (int bj = 0; bj < 2; ++bj)
#pragma unroll
            for (int n = 0; n < 2; ++n) ks[bj][n] = (f32x4){0.f, 0.f, 0.f, 0.f};
#pragma unroll
        for (int ai = 0; ai < 2; ++ai)
#pragma unroll
            for (int m = 0; m < 4; ++m) { const int row = row0 + ai * HALF + m * 16; const f32x2v rs = lf.RS[((u.pm >> 3) & 3) * BM + (row & (BM - 1))];
                bf16_t* rowp = (t == 0) ? base + (size_t)row * 1024 + col0 : base + ((size_t)((row >> 11) * 16 + (col0 >> 6)) * 2048 + (row & 2047)) * 64 + (col0 & 63);
#pragma unroll
                for (int bj = 0; bj < 2; ++bj) { const f32x4 v0 = (acc[ai][bj][m][0] - cs[bj][0] * rs.x) * rs.y + bw[bj][0], v1 = (acc[ai][bj][m][1] - cs[bj][1] * rs.x) * rs.y + bw[bj][1];
                    ks[bj][0] += v0; ks[bj][1] += v1;
                    const f32x4 s0 = v0 * sc, s1 = v1 * sc;
                    u32x4 w; w.x = cvt_pk_bf16(s0[0], s0[1]); w.y = cvt_pk_bf16(s0[2], s0[3]); w.z = cvt_pk_bf16(s1[0], s1[1]); w.w = cvt_pk_bf16(s1[2], s1[3]);
                    *(u32x4*)(rowp + ((t == 0) ? bj * HALF : bj * (2 * 2048 * 64))) = w; } }
        if (u.pn == 7) {
#pragma unroll
            for (int bj = 0; bj < 2; ++bj)
#pragma unroll
                for (int n = 0; n < 2; ++n)
#pragma unroll
                    for (int e = 0; e < 4; ++e) { float x = ks[bj][n][e]; x += __shfl_xor(x, 1); x += __shfl_xor(x, 2); x += __shfl_xor(x, 4); x += __shfl_xor(x, 8);
                        if (fr == 0) atomicAdd(ksum + (size_t)u.pm * 256 + bj * HALF + wc * 32 + 8 * fq + 4 * n + e, x); }
        }
    }
};
template <class Epi, class Sched, bool ALIGN_EPI = false, bool SP2 = false>
__device__ __forceinline__ void gemm_phase(PG8_LAS unsigned char* lds, const Gemm g, const Sched& S, const Epi& E) {
    const int tid = threadIdx.x, wid = __builtin_amdgcn_readfirstlane(tid >> 6), lane = tid & 63, wr = wid >> 2, wc = wid & 3, fr = lane & 15, fq = lane >> 4;
    const int K = g.K, nt = K / BK;
    constexpr bool PRESTAGE = SP2 && ALIGN_EPI && !Epi::AFTER_DRAIN; constexpr int NV = Epi::NVMEM < 55 ? Epi::NVMEM : 55;
    unsigned voffA[2], voffB[2];
#pragma unroll
    for (int i = 0; i < 2; ++i) { int R, C; stage_rc(tid * 16 + i * 8192, R, C); const int Rb = Epi::PERM ? ((R & ~31) + perm32(R & 31)) : R;
        voffA[i] = (unsigned)(R * K + C) * 2u; voffB[i] = (unsigned)(Rb * K + C) * 2u; }
    const size_t kstep = (size_t)(BK * 2);
    const size_t hstep = (size_t)HALF * K * 2;
    const size_t tstep = 2 * hstep;
    const unsigned ldsw = (unsigned)wid * 1024u;
    const int aoff = lds_byte(wr * 64 + fr, fq * 8), boff = lds_byte(wc * 32 + fr, fq * 8);
#define PG8_SA(b, h) (((b) * 2 + (h)) * HTB)
#define PG8_SB(b, h) ((4 + (b) * 2 + (h)) * HTB)
#define PG8_STAGE(bufoff, gbase, voff) do { _Pragma("unroll") for (int _i = 0; _i < 2; ++_i) \
        __builtin_amdgcn_global_load_lds((const unsigned*)((const char*)(gbase) + (voff)[_i]), (PG8_LAS unsigned*)(lds + (bufoff) + ldsw + _i * 8192), 16, 0, 0); } while (0)
#define PG8_LDA(dst, b, h) do { _Pragma("unroll") for (int m = 0; m < 4; ++m) _Pragma("unroll") for (int k = 0; k < 2; ++k) dst[m][k] = *(const PG8_LAS bf16x8*)(lds + PG8_SA(b, h) + aoff + m * 2048 + k * 1024); } while (0)
#define PG8_LDB(dst, b, h) do { _Pragma("unroll") for (int n = 0; n < 2; ++n) _Pragma("unroll") for (int k = 0; k < 2; ++k) dst[n][k] = *(const PG8_LAS bf16x8*)(lds + PG8_SB(b, h) + boff + n * 2048 + k * 1024); } while (0)
#define PG8_MMA(ai, bj, At, Bt) do { __builtin_amdgcn_s_setprio(1); _Pragma("unroll") for (int m = 0; m < 4; ++m) _Pragma("unroll") for (int n = 0; n < 2; ++n) _Pragma("unroll") for (int k = 0; k < 2; ++k) \
        acc[ai][bj][m][n] = __builtin_amdgcn_mfma_f32_16x16x32_bf16(Bt[n][k], At[m][k], acc[ai][bj][m][n], 0, 0, 0); __builtin_amdgcn_s_setprio(0); } while (0)
#define PG8_WAIT_V(n) asm volatile("s_waitcnt vmcnt(" #n ")" ::: "memory")
#define PG8_WAIT_VN(n) asm volatile("s_waitcnt vmcnt(%0)" :: "n"(n) : "memory")
#define PG8_WAIT_L(n) asm volatile("s_waitcnt lgkmcnt(" #n ")" ::: "memory")
#define PG8_BAR __builtin_amdgcn_s_barrier()
#define PG8_SCHED __builtin_amdgcn_sched_barrier(0)
    Unit cur, nxt; int ui = 0;
    if (!S.next(0, cur)) return;
    f32x4 acc[2][2][4][2];
#pragma unroll
    for (int a = 0; a < 2; ++a)
#pragma unroll
        for (int b = 0; b < 2; ++b)
#pragma unroll
            for (int m = 0; m < 4; ++m)
#pragma unroll
                for (int n = 0; n < 2; ++n) acc[a][b][m][n] = (f32x4){0.f, 0.f, 0.f, 0.f};
    bf16x8 At[4][2], B0[2][2], B1[2][2];
    const char* cA = (const char*)g.A + (size_t)cur.pm * tstep; const char* cB = (const char*)g.Bt + (size_t)cur.pn * tstep;
    S.a_ready(cur);
    if constexpr (SP2) {
        PG8_STAGE(PG8_SB(0, 0), cB, voffB); PG8_STAGE(PG8_SB(0, 1), cB + hstep, voffB); PG8_STAGE(PG8_SA(0, 0), cA, voffA); PG8_STAGE(PG8_SA(0, 1), cA + hstep, voffA);
        if (wr == 1) PG8_BAR;
        PG8_WAIT_V(2); PG8_BAR;
        PG8_STAGE(PG8_SB(1, 0), cB + kstep, voffB); PG8_STAGE(PG8_SA(1, 0), cA + kstep, voffA); PG8_STAGE(PG8_SB(1, 1), cB + hstep + kstep, voffB);
        if constexpr (PRESTAGE) { PG8_STAGE(PG8_SA(1, 1), cA + hstep + kstep, voffA); PG8_WAIT_V(8); PG8_BAR;
#pragma unroll
            for (int i_ = 0; i_ < NV; ++i_) __builtin_amdgcn_global_load_lds((const unsigned*)((const char*)g.A + tid * 4), (PG8_LAS unsigned*)(lds + STAGE_BYTES + wid * 256), 4, 0, 0);
        } else {
        PG8_WAIT_V(6); PG8_BAR;
        }
    } else {
        PG8_STAGE(PG8_SB(0, 0), cB, voffB); PG8_STAGE(PG8_SA(0, 0), cA, voffA); PG8_STAGE(PG8_SB(0, 1), cB + hstep, voffB); PG8_STAGE(PG8_SA(0, 1), cA + hstep, voffA);
        if (wr == 1) PG8_BAR;
        PG8_WAIT_V(4); PG8_BAR;
        PG8_STAGE(PG8_SB(1, 0), cB + kstep, voffB); PG8_STAGE(PG8_SA(1, 0), cA + kstep, voffA); PG8_STAGE(PG8_SB(1, 1), cB + hstep + kstep, voffB);
        PG8_WAIT_V(6); PG8_BAR;
    }
    for (;;) {
        const bool has_next = S.next(ui + 1, nxt);
        const char* nA = has_next ? (const char*)g.A + (size_t)nxt.pm * tstep : cA; const char* nB = has_next ? (const char*)g.Bt + (size_t)nxt.pn * tstep : cB;
        for (int t = 0; t < nt; t += 2) {
            const bool last = (t == nt - 2);
            const int tsel = PRESTAGE ? t : 1;
            const char* a1 = cA + (size_t)(t + 1) * kstep;
            const char* a2 = last ? nA : cA + (size_t)(t + 2) * kstep; const char* b2 = last ? nB : cB + (size_t)(t + 2) * kstep;
            const char* a3 = a2 + kstep; const char* b3 = b2 + kstep;
            if (last && has_next) S.a_ready(nxt);
#define PG8_WAIT_SEL() asm volatile("s_cmp_eq_u32 %0, 0\n\ts_cbranch_scc1 1f\n\ts_waitcnt vmcnt(8)\n\ts_branch 2f\n1:\n\ts_waitcnt vmcnt(%1)\n2:" :: "s"(tsel), "n"(10 + NV) : "memory", "scc")
            if constexpr (SP2) {
            PG8_LDB(B0, 0, 0); PG8_LDB(B1, 0, 1); PG8_SCHED; PG8_LDA(At, 0, 0); PG8_STAGE(PG8_SA(1, 1), a1 + hstep, voffA);
            PG8_WAIT_SEL(); PG8_WAIT_L(0); PG8_BAR; PG8_MMA(0, 0, At, B0); PG8_MMA(0, 1, At, B1); PG8_BAR; PG8_SCHED;
            PG8_LDA(At, 0, 1); PG8_STAGE(PG8_SB(0, 0), b2, voffB); PG8_STAGE(PG8_SB(0, 1), b2 + hstep, voffB); PG8_STAGE(PG8_SA(0, 0), a2, voffA);
            PG8_WAIT_SEL(); PG8_WAIT_L(0); PG8_BAR; PG8_MMA(1, 0, At, B0); PG8_MMA(1, 1, At, B1); PG8_BAR; PG8_SCHED;
            PG8_LDB(B0, 1, 0); PG8_LDB(B1, 1, 1); PG8_SCHED; PG8_LDA(At, 1, 0); PG8_STAGE(PG8_SA(0, 1), a2 + hstep, voffA);
            PG8_WAIT_SEL(); PG8_WAIT_L(0); PG8_BAR; PG8_MMA(0, 0, At, B0); PG8_MMA(0, 1, At, B1); PG8_BAR; PG8_SCHED;
            PG8_LDA(At, 1, 1); PG8_STAGE(PG8_SB(1, 0), b3, voffB); PG8_STAGE(PG8_SB(1, 1), b3 + hstep, voffB); PG8_STAGE(PG8_SA(1, 0), a3, voffA);
            PG8_WAIT_V(8); PG8_WAIT_L(0); PG8_BAR; PG8_MMA(1, 0, At, B0); PG8_MMA(1, 1, At, B1); PG8_BAR; PG8_SCHED;
            }
#undef PG8_WAIT_SEL
            else {
            PG8_LDB(B0, 0, 0); PG8_SCHED; PG8_LDA(At, 0, 0); PG8_STAGE(PG8_SA(1, 1), a1 + hstep, voffA);
            PG8_WAIT_L(8); PG8_BAR; PG8_WAIT_L(0); PG8_MMA(0, 0, At, B0); PG8_BAR; PG8_SCHED;
            PG8_LDB(B1, 0, 1); PG8_STAGE(PG8_SB(0, 0), b2, voffB);
            PG8_BAR; PG8_WAIT_L(0); PG8_MMA(0, 1, At, B1); PG8_BAR;
            PG8_LDA(At, 0, 1); PG8_STAGE(PG8_SA(0, 0), a2, voffA);
            PG8_BAR; PG8_WAIT_L(0); PG8_MMA(1, 0, At, B0); PG8_BAR; PG8_SCHED;
            PG8_STAGE(PG8_SB(0, 1), b2 + hstep, voffB);
            PG8_WAIT_V(6); PG8_BAR; PG8_MMA(1, 1, At, B1); PG8_BAR;
            PG8_LDB(B0, 1, 0); PG8_SCHED; PG8_LDA(At, 1, 0); PG8_STAGE(PG8_SA(0, 1), a2 + hstep, voffA);
            PG8_WAIT_L(8); PG8_BAR; PG8_WAIT_L(0); PG8_MMA(0, 0, At, B0); PG8_BAR; PG8_SCHED;
            PG8_LDB(B1, 1, 1); PG8_STAGE(PG8_SB(1, 0), b3, voffB);
            PG8_BAR; PG8_WAIT_L(0); PG8_MMA(0, 1, At, B1); PG8_BAR;
            PG8_LDA(At, 1, 1); PG8_STAGE(PG8_SA(1, 0), a3, voffA);
            PG8_BAR; PG8_WAIT_L(0); PG8_MMA(1, 0, At, B0); PG8_BAR; PG8_SCHED;
            PG8_STAGE(PG8_SB(1, 1), b3 + hstep, voffB);
            PG8_WAIT_V(6); PG8_BAR; PG8_MMA(1, 1, At, B1); PG8_BAR;
            }
        }
        if constexpr (ALIGN_EPI) { if (wr == 0) PG8_BAR; }
        if constexpr (PRESTAGE) { if (has_next) PG8_STAGE(PG8_SA(1, 1), nA + kstep + hstep, voffA); }
        if constexpr (!Epi::AFTER_DRAIN) { E(acc, cur, wr, wc, fr, fq, lds + STAGE_BYTES, tid); S.done(cur); }
        if (!has_next) break;
#pragma unroll
        for (int a = 0; a < 2; ++a)
#pragma unroll
            for (int b = 0; b < 2; ++b)
#pragma unroll
                for (int m = 0; m < 4; ++m)
#pragma unroll
                    for (int n = 0; n < 2; ++n) acc[a][b][m][n] = (f32x4){0.f, 0.f, 0.f, 0.f};
        cur = nxt; cA = nA; cB = nB; ++ui;
        if constexpr (ALIGN_EPI) { if (wr == 1) PG8_BAR; }
    }
    PG8_WAIT_V(0);
    if constexpr (!ALIGN_EPI) { if (wr == 0) PG8_BAR; }
    PG8_BAR;
    if constexpr (Epi::AFTER_DRAIN) { E.fused(acc, cur, wr, wc, fr, fq, lds, wid, lane); S.done(cur); }
#undef PG8_SA
#undef PG8_SB
#undef PG8_STAGE
#undef PG8_LDA
#undef PG8_LDB
#undef PG8_MMA
#undef PG8_WAIT_V
#undef PG8_WAIT_VN
#undef PG8_WAIT_L
#undef PG8_BAR
#undef PG8_SCHED
}
}
#ifndef PG8_SP2
#define PG8_SP2 true
#endif
#ifndef PG8_ALIGN
#define PG8_ALIGN true
#endif
constexpr int NWAVES = 8;
constexpr int BATCH = 32, SEQ = 2048, D = 1024, FF = 2816, NGU = 2 * FF, NQKV = 3 * D, HD = 64;
constexpr int M = BATCH * SEQ;
constexpr int NHA = 12, NHB = 4, WIDTH_A = NHA * HD, WIDTH_B = NHB * HD;
constexpr float LN_EPS = 1e-5f;
constexpr float ALPHA = 1.189207115002721f;
constexpr float QSCALE = 0.125f * 1.4426950408889634f;
constexpr size_t MiB = 1u << 20;
constexpr size_t WS_CTL = 0, WS_KS = 1 * MiB, CTL_ZERO_BYTES = 2 * MiB;
constexpr size_t WS_W1T = 2 * MiB, WS_W2T = 13 * MiB, WS_WINT = 19 * MiB, WS_WOT = 25 * MiB, WS_W3T = 27 * MiB, WS_W4T = 38 * MiB;
constexpr size_t WS_VEC = 44 * MiB;
constexpr size_t WS_PS = 45 * MiB;
constexpr size_t WS_RS = 51 * MiB;
constexpr size_t WS_AB = 64 * MiB;
constexpr size_t WS_YH = 192 * MiB;
constexpr size_t WS_R1 = 320 * MiB;
constexpr size_t WS_OB = 704 * MiB;
constexpr size_t WS_END = 832 * MiB;
static_assert(WS_W1T + (size_t)NGU * D * 2 <= WS_W2T && WS_W2T + (size_t)D * FF * 2 <= WS_WINT && WS_WINT + (size_t)NQKV * D * 2 <= WS_WOT && WS_WOT + (size_t)D * D * 2 <= WS_W3T &&
              WS_W3T + (size_t)NGU * D * 2 <= WS_W4T && WS_W4T + (size_t)D * FF * 2 <= WS_VEC && WS_VEC + (size_t)(2 * NQKV + 2 * NGU) * 4 <= WS_PS && WS_PS + (size_t)3 * M * 32 <= WS_RS &&
              WS_RS + (size_t)2 * M * 8 <= WS_AB && WS_AB + (size_t)M * D * 2 <= WS_YH && WS_YH + (size_t)M * D * 2 <= WS_R1 &&
              WS_R1 + (size_t)3 * M * D * 2 <= WS_OB && WS_R1 + (size_t)M * FF * 2 <= WS_OB && WS_OB + (size_t)M * D * 2 <= WS_END, "d_ws map");
constexpr int CW_BAR = 4096;
constexpr int CW_LBAR = 8192;
constexpr int CW_BAD = 12288;
constexpr int CW_QUEUE = 16384;
constexpr int RING_OFF = 0, RING_BYTES = 131072;
constexpr int LDSCTL_OFF = RING_BYTES + 8192, MISC_OFF = LDSCTL_OFF + 320;
constexpr int RSL_OFF = 147456;
constexpr int LDS_BYTES = 155648;
static_assert(MISC_OFF + 128 <= RSL_OFF && RSL_OFF + 8192 <= LDS_BYTES, "LDS map");
#define GAS __attribute__((address_space(1)))
#define LAS __attribute__((address_space(3)))
typedef unsigned short bf16;
typedef unsigned v4u __attribute__((ext_vector_type(4)));
typedef float f32x4 __attribute__((ext_vector_type(4)));
typedef short bf16x8 __attribute__((ext_vector_type(8)));
typedef GAS unsigned gu32;
typedef GAS unsigned long long gu64;
#define RLX_AGENT __ATOMIC_RELAXED, __HIP_MEMORY_SCOPE_AGENT
#define LDS_WAIT() asm volatile("s_waitcnt lgkmcnt(0)" ::: "memory")
#define VM_WAIT() asm volatile("s_waitcnt vmcnt(0)" ::: "memory")
__device__ __forceinline__ unsigned long long rt() { return __builtin_amdgcn_s_memrealtime(); }
__device__ __forceinline__ unsigned f2bf(float f) { unsigned u = __builtin_bit_cast(unsigned, f); return (u + 0x7fffu + ((u >> 16) & 1u)) >> 16; }
__device__ __forceinline__ unsigned pk2(float lo, float hi) { return f2bf(lo) | (f2bf(hi) << 16); }
#define XB_TMO      128
#define XB_XCNT(j)  (256  + 64 * (j))
#define XB_XSUB(j)  (1280 + 64 * (j))
#define XB_XGEN(j)  (2304 + 64 * (j))
#define XB_TOP      3328
#define XB_TOPGEN   3392
#define XCD_BAR_WORDS 3456
#define XB_SPIN_CAP (1u << 18)

__device__ __forceinline__ unsigned xb_ld(unsigned* p)              { return __hip_atomic_load(p, __ATOMIC_RELAXED, __HIP_MEMORY_SCOPE_AGENT); }
__device__ __forceinline__ unsigned xb_add(unsigned* p, unsigned v) { return __hip_atomic_fetch_add(p, v, __ATOMIC_RELAXED, __HIP_MEMORY_SCOPE_AGENT); }
__device__ __forceinline__ unsigned xb_xcc_id() { return (unsigned)__builtin_amdgcn_s_getreg((3 << 11) | 20) & 0xFu; }
#define XB_SPIN(cond, bar) do { unsigned _sp = 0; while (cond) { __builtin_amdgcn_s_sleep(1); \
    if ((++_sp & 255u) == 0u) { if (xb_ld(&(bar)[XB_TMO])) break; if (_sp > XB_SPIN_CAP) { atomicAdd(&(bar)[XB_TMO], 1u); break; } } } } while (0)

struct XcdBarrier {
    unsigned* bar; unsigned x;
    volatile LAS unsigned* st;
};

__device__ __forceinline__ XcdBarrier xcd_barrier_post(unsigned* bar, volatile LAS unsigned* st) {
    XcdBarrier b; b.bar = bar; b.x = xb_xcc_id(); b.st = st;
    if (threadIdx.x == 0) (void)xb_add(&bar[XB_XCNT(b.x)], 1u);
    return b;
}
__device__ __forceinline__ void xcd_barrier_complete(unsigned* bar, unsigned x, unsigned& nloc, unsigned& nx) {
    const unsigned G = gridDim.x * gridDim.y * gridDim.z;
    unsigned sum, cnt, mine, sp = 0u;
    for (;;) {
        sum = 0u; cnt = 0u; mine = 0u;
#pragma unroll
        for (unsigned j = 0; j < 16; ++j) { const unsigned c = xb_ld(&bar[XB_XCNT(j)]); sum += c; cnt += (c > 0u) ? 1u : 0u; mine = (j == x) ? c : mine; }
        if (sum == G) break;
        __builtin_amdgcn_s_sleep(1);
        if ((++sp & 255u) == 0u) { if (xb_ld(&bar[XB_TMO])) break; if (sp > XB_SPIN_CAP) { atomicAdd(&bar[XB_TMO], 1u); break; } }
    }
    nloc = mine > 0u ? mine : 1u; nx = cnt > 0u ? cnt : 1u;
}

__device__ __forceinline__ void xcd_barrier(const XcdBarrier& b) {
    asm volatile("s_waitcnt vmcnt(0)" ::: "memory");
    __syncthreads();
    if (threadIdx.x == 0) {
        unsigned* bar = b.bar;
        __builtin_amdgcn_s_waitcnt(0);
        unsigned nloc = b.st[0], nx = b.st[1];
        if (nloc == 0u) { xcd_barrier_complete(bar, b.x, nloc, nx); b.st[0] = nloc; b.st[1] = nx; }
        const unsigned old = xb_add(&bar[XB_XSUB(b.x)], 1u);
        const unsigned gen = old / nloc;
        if (old + 1u == (gen + 1u) * nloc) {
            __builtin_amdgcn_fence(__ATOMIC_RELEASE, "agent");
            asm volatile("s_waitcnt vmcnt(0)" ::: "memory");
            const unsigned og = xb_add(&bar[XB_TOP], 1u);
            const unsigned tg = og / nx;
            if (og + 1u == (tg + 1u) * nx) xb_add(&bar[XB_TOPGEN], 1u);
            else XB_SPIN(xb_ld(&bar[XB_TOPGEN]) == tg, bar);
            __builtin_amdgcn_fence(__ATOMIC_ACQUIRE, "agent");
            xb_add(&bar[XB_XGEN(b.x)], 1u);
            asm volatile("s_waitcnt vmcnt(0)" ::: "memory");
        } else {
            XB_SPIN(xb_ld(&bar[XB_XGEN(b.x)]) == gen, bar);
            __builtin_amdgcn_fence(__ATOMIC_ACQUIRE, "agent");
            asm volatile("s_waitcnt vmcnt(0)" ::: "memory");
        }
    }
    __syncthreads();
}
__device__ __forceinline__ void seam(const XcdBarrier& b, int local, gu32* lcnt, unsigned target) {
    if (local) {
        asm volatile("s_waitcnt vmcnt(0)" ::: "memory");
        __syncthreads();
        if (threadIdx.x == 0) {
            __builtin_amdgcn_s_waitcnt(0);
            (void)xb_add((unsigned*)lcnt, 1u);
            XB_SPIN(xb_ld((unsigned*)lcnt) < target, b.bar);
            __builtin_amdgcn_fence(__ATOMIC_ACQUIRE, "agent");
            asm volatile("s_waitcnt vmcnt(0)" ::: "memory");
        }
        __syncthreads();
    } else xcd_barrier(b);
}
struct Frame {
    LAS unsigned char* lds;
    volatile LAS unsigned* MISC;
    gu32* ctl;
    int tid, lane, wave;
    int local;
    int vcu, G;
    const float* x; float* out;
    const float *g1w, *u1w, *d1w, *ln1g, *ln1b, *win, *wout, *ln2g, *ln2b, *g2w, *u2w, *d2w, *ln3g, *ln3b;
    bf16 *W1T, *W2T, *WINT, *WOT, *W3T, *W4T;
    bf16 *AB, *HB, *QB, *KB, *VB, *OB;
    unsigned short* YH;
    pg8::f32x2v *PS1, *PS2, *PS3, *RS1, *RS2;
    float *KS, *CSIN, *BWIN, *CS3, *BW3;
};

__device__ __forceinline__ float wave_sum(float v) {
#pragma unroll
    for (int o = 1; o < 64; o <<= 1) v += __shfl_xor(v, o);
    return v;
}
__device__ __forceinline__ int dest_row(int kind, int n0) {
    if (kind == 0) return n0;
    if (kind == 1) return 256 * (n0 >> 7) + (n0 & 127);
    if (kind == 2) return 256 * (n0 >> 7) + 128 + (n0 & 127);
    if (n0 < WIDTH_A) return n0;
    if (n0 < 2 * WIDTH_A) return D + (n0 - WIDTH_A);
    if (n0 < 3 * WIDTH_A) return 2 * D + (n0 - 2 * WIDTH_A);
    if (n0 < 3 * WIDTH_A + WIDTH_B) return WIDTH_A + (n0 - 3 * WIDTH_A);
    if (n0 < 3 * WIDTH_A + 2 * WIDTH_B) return D + WIDTH_A + (n0 - 3 * WIDTH_A - WIDTH_B);
    return 2 * D + WIDTH_A + (n0 - 3 * WIDTH_A - 2 * WIDTH_B);
}
__device__ __forceinline__ void p0_transpose_item(const float* W, int K, int N, bf16* WT, int kind, const float* gain, LAS float* scr, int item, int lane) {
    const int nblk = N / 32, kb = item / nblk, nb = item % nblk, k0 = 64 * kb, n0 = 32 * nb;
    const int drow0 = dest_row(kind, n0);
#pragma unroll 8
    for (int i = 0; i < 32; ++i) { const int kk = 2 * i + (lane >> 5); float wv = W[(size_t)(k0 + kk) * N + n0 + (lane & 31)]; if (gain) wv *= gain[k0 + kk]; scr[kk * 33 + (lane & 31)] = wv; }
    LDS_WAIT(); asm volatile("" ::: "memory");
    const int c = lane & 7;
#pragma unroll
    for (int j = 0; j < 4; ++j) { const int n = (lane >> 3) + 8 * j; const LAS float* s = scr + (8 * c) * 33 + n;
        v4u o; o.x = pk2(s[0 * 33], s[1 * 33]); o.y = pk2(s[2 * 33], s[3 * 33]); o.z = pk2(s[4 * 33], s[5 * 33]); o.w = pk2(s[6 * 33], s[7 * 33]);
        *(GAS v4u*)(WT + (size_t)(drow0 + n) * K + k0 + 8 * c) = o; }
    LDS_WAIT(); asm volatile("" ::: "memory");
}
__device__ __forceinline__ void cvt_row_to_bf16(int lane, const float* xrow, bf16* orow) {
    const GAS f32x4* xr = (const GAS f32x4*)xrow + lane;
    f32x4 v[4];
#pragma unroll
    for (int j = 0; j < 4; ++j) v[j] = xr[64 * j];
    GAS unsigned long long* o8 = (GAS unsigned long long*)orow + lane;
#pragma unroll
    for (int j = 0; j < 4; ++j) o8[64 * j] = (unsigned long long)pk2(v[j].x, v[j].y) | ((unsigned long long)pk2(v[j].z, v[j].w) << 32);
}
__device__ __forceinline__ void fold_task(Frame& F, const float* W, int N, int kind, const float* g, const float* b, float* cs, float* bw, int task) {
    const int n = 64 * task + F.lane; float a = 0.f, c = 0.f;
#pragma unroll 8
    for (int k = 128 * F.wave; k < 128 * F.wave + 128; ++k) { const float w = W[(size_t)k * N + n]; const unsigned hb = pk2(w * g[k], 0.f) & 0xffffu; a += __uint_as_float(hb << 16); c += w * b[k]; }
    LAS float* T = (LAS float*)(F.lds + RING_OFF);
    T[(F.wave * 64 + F.lane) * 2] = a; T[(F.wave * 64 + F.lane) * 2 + 1] = c;
    __syncthreads();
    if (F.tid < 64) { float sa = 0.f, sc = 0.f;
#pragma unroll
        for (int w = 0; w < 8; ++w) { sa += T[(w * 64 + F.tid) * 2]; sc += T[(w * 64 + F.tid) * 2 + 1]; }
        const int nd = dest_row(kind, n & ~31) + (n & 31); cs[nd] = sa; bw[nd] = sc; }
    __syncthreads();
}
__device__ __forceinline__ void p0_prologue(Frame& F) {
    LAS float* scr = (LAS float*)(F.lds + RING_OFF + F.wave * 16384);
    const int gw = F.vcu * NWAVES + F.wave, NGW = F.G * NWAVES;
    for (int t = F.vcu; t < NQKV / 64 + 2 * (FF / 64); t += F.G) {
        if (t < NQKV / 64) fold_task(F, F.win, NQKV, 3, F.ln1g, F.ln1b, F.CSIN, F.BWIN, t);
        else if (t < NQKV / 64 + FF / 64) fold_task(F, F.g2w, FF, 1, F.ln2g, F.ln2b, F.CS3, F.BW3, t - NQKV / 64);
        else fold_task(F, F.u2w, FF, 2, F.ln2g, F.ln2b, F.CS3, F.BW3, t - NQKV / 64 - FF / 64);
    }
    constexpr int I_GU = (D / 64) * (FF / 32), I_DN = (FF / 64) * (D / 32), I_IN = (D / 64) * (NQKV / 32), I_OUT = (D / 64) * (D / 32);
    constexpr int NITEMS = 4 * I_GU + 2 * I_DN + I_IN + I_OUT;
    for (int it = gw; it < NITEMS; it += NGW) {
        int r = it;
        if (r < I_GU) { p0_transpose_item(F.g1w, D, FF, F.W1T, 1, nullptr, scr, r, F.lane); continue; } r -= I_GU;
        if (r < I_GU) { p0_transpose_item(F.u1w, D, FF, F.W1T, 2, nullptr, scr, r, F.lane); continue; } r -= I_GU;
        if (r < I_DN) { p0_transpose_item(F.d1w, FF, D, F.W2T, 0, nullptr, scr, r, F.lane); continue; } r -= I_DN;
        if (r < I_IN) { p0_transpose_item(F.win, D, NQKV, F.WINT, 3, F.ln1g, scr, r, F.lane); continue; } r -= I_IN;
        if (r < I_OUT) { p0_transpose_item(F.wout, D, D, F.WOT, 0, nullptr, scr, r, F.lane); continue; } r -= I_OUT;
        if (r < I_GU) { p0_transpose_item(F.g2w, D, FF, F.W3T, 1, F.ln2g, scr, r, F.lane); continue; } r -= I_GU;
        if (r < I_GU) { p0_transpose_item(F.u2w, D, FF, F.W3T, 2, F.ln2g, scr, r, F.lane); continue; } r -= I_GU;
        p0_transpose_item(F.d2w, FF, D, F.W4T, 0, nullptr, scr, r, F.lane);
    }
    for (int m = gw; m < M; m += NGW) cvt_row_to_bf16(F.lane, F.x + (size_t)m * D, F.AB + (size_t)m * D);
}
__device__ __forceinline__ void fill_row_stats(Frame& F, const pg8::f32x2v* PS, int pm0) {
    LAS pg8::f32x2v* T = (LAS pg8::f32x2v*)(F.lds + RSL_OFF);
    const int k = F.tid >> 7, rl = (F.tid & 127) * 2, pm = (pm0 & ~31) + 8 * k + (pm0 & 7);
#pragma unroll
    for (int e = 0; e < 2; ++e) { const size_t row = (size_t)pm * 256 + rl + e;
        const f32x4 a = *(const GAS f32x4*)(PS + row * 4), b = *(const GAS f32x4*)(PS + row * 4 + 2);
        const float s1 = (a.x + a.z) + (b.x + b.z), s2 = (a.y + a.w) + (b.y + b.w);
        const float mean = s1 * (1.f / D), var = fmaxf(s2 * (1.f / D) - mean * mean, 0.f);
        T[k * 256 + rl + e] = (pg8::f32x2v){mean, 1.f / sqrtf(var + LN_EPS)}; }
    __syncthreads();
}
__device__ __forceinline__ void final_phase(Frame& F) {
    const int gw = F.vcu * NWAVES + F.wave, NGW = F.G * NWAVES;
    f32x4 gg[2][2], bb[2][2];
#pragma unroll
    for (int j = 0; j < 2; ++j)
#pragma unroll
        for (int n = 0; n < 2; ++n) { gg[j][n] = *(const GAS f32x4*)(F.ln3g + 512 * j + 8 * F.lane + 4 * n); bb[j][n] = *(const GAS f32x4*)(F.ln3b + 512 * j + 8 * F.lane + 4 * n); }
    for (int m = gw; m < M; m += NGW) {
        const f32x4 a = *(const GAS f32x4*)(F.PS3 + (size_t)m * 4), b = *(const GAS f32x4*)(F.PS3 + (size_t)m * 4 + 2);
        const float s1 = (a.x + a.z) + (b.x + b.z), s2 = (a.y + a.w) + (b.y + b.w);
        const float mean = s1 * (1.f / D), var = fmaxf(s2 * (1.f / D) - mean * mean, 0.f), rstd = 1.f / sqrtf(var + LN_EPS);
#pragma unroll
        for (int j = 0; j < 2; ++j) { const v4u hw = *(const GAS v4u*)(F.YH + (size_t)m * D + 512 * j + 8 * F.lane);
            const pg8::f32x2v a0 = pg8::unpk_f16(hw.x), a1 = pg8::unpk_f16(hw.y), a2 = pg8::unpk_f16(hw.z), a3 = pg8::unpk_f16(hw.w);
            const f32x4 o0 = ((f32x4){a0.x, a0.y, a1.x, a1.y} - mean) * rstd * gg[j][0] + bb[j][0], o1 = ((f32x4){a2.x, a2.y, a3.x, a3.y} - mean) * rstd * gg[j][1] + bb[j][1];
            GAS f32x4* op = (GAS f32x4*)(F.out + (size_t)m * D + 512 * j + 8 * F.lane); op[0] = o0; op[1] = o1; }
    }
}
namespace att {
typedef float f32x16 __attribute__((ext_vector_type(16)));
typedef short bf16x8 __attribute__((ext_vector_type(8)));
typedef short s16x4 __attribute__((ext_vector_type(4)));
typedef short v4i16_t __attribute__((ext_vector_type(4)));
typedef float f32x2_t __attribute__((ext_vector_type(2)));
typedef __bf16 bf16x2_t __attribute__((ext_vector_type(2)));
constexpr int ST_O = 65536, ST_M = 131072, ST_L = 131072 + 2048;
constexpr float THR = 6.0f;
constexpr float LOG2E = 1.4426950408889634f;
constexpr int UNITS_PER_BATCH = NHB * 8 + NHA * 4, UNITS_PER_XCD = (BATCH / 8) * UNITS_PER_BATCH;
__device__ __forceinline__ unsigned cvt2(float lo, float hi) { f32x2_t v = {lo, hi}; bf16x2_t b = __builtin_convertvector(v, bf16x2_t); return __builtin_bit_cast(unsigned, b); }
__device__ __forceinline__ s16x4 vtr(LAS const char* p) { return __builtin_bit_cast(s16x4, __builtin_amdgcn_ds_read_tr16_b64_v4i16((LAS v4i16_t*)p)); }
__device__ __forceinline__ float max_raw(float a, float b) { float r; asm("v_max_f32 %0, %1, %2" : "=v"(r) : "v"(a), "v"(b)); return r; }
#define ATT_RM_BODY "v_max3_f32 %0, %3, %4, %5\n\tv_max3_f32 %1, %6, %7, %8\n\tv_max3_f32 %2, %9, %10, %11\n\tv_max3_f32 %0, %0, %1, %2\n\tv_max3_f32 %1, %12, %13, %14\n\tv_max3_f32 %2, %15, %16, %17\n\tv_max3_f32 %1, %1, %2, %18\n\tv_max_f32 %0, %0, %1"
#define ATT_RM_OPS(s) "v"(s[0]), "v"(s[1]), "v"(s[2]), "v"(s[3]), "v"(s[4]), "v"(s[5]), "v"(s[6]), "v"(s[7]), "v"(s[8]), "v"(s[9]), "v"(s[10]), "v"(s[11]), "v"(s[12]), "v"(s[13]), "v"(s[14]), "v"(s[15])
template <int PAD> __device__ __forceinline__ float rowmax16(const f32x16& s) {
    float t0, t1, t2;
    if (PAD == 2) asm("s_nop 15\n\ts_nop 7\n\t" ATT_RM_BODY : "=&v"(t0), "=&v"(t1), "=&v"(t2) : ATT_RM_OPS(s));
    else if (PAD == 1) asm("s_nop 7\n\t" ATT_RM_BODY : "=&v"(t0), "=&v"(t1), "=&v"(t2) : ATT_RM_OPS(s));
    else asm(ATT_RM_BODY : "=&v"(t0), "=&v"(t1), "=&v"(t2) : ATT_RM_OPS(s));
    return t0;
}
__device__ __forceinline__ float rowmax16_after(const f32x16& s, float dep) {
    float t0, t1, t2;
    asm(ATT_RM_BODY : "=&v"(t0), "=&v"(t1), "=&v"(t2) : ATT_RM_OPS(s), "v"(dep));
    return t0;
}
__device__ __forceinline__ float swap_max(float v) { auto rr = __builtin_amdgcn_permlane32_swap(__float_as_uint(v), __float_as_uint(v), false, false); return max_raw(__uint_as_float(rr[0]), __uint_as_float(rr[1])); }
__device__ __forceinline__ float swap_add(float v) { auto rr = __builtin_amdgcn_permlane32_swap(__float_as_uint(v), __float_as_uint(v), false, false); return __uint_as_float(rr[0]) + __uint_as_float(rr[1]); }
#define ATT_CROW(r) (((r) & 3) + 8 * ((r) >> 2))
__device__ __forceinline__ void touch_line(const void* gptr, unsigned lds_dst  ) {
    unsigned keep;
    asm volatile("s_mov_b32 %0, m0\n\ts_mov_b32 m0, %2\n\ts_nop 0\n\tglobal_load_lds_dword %1, off\n\ts_mov_b32 m0, %0" : "=&s"(keep) : "v"(gptr), "s"(lds_dst) : "memory");
}
constexpr int ST_DUMMY = ST_L + 1024;

struct LaneC {
    LAS char *kw_e, *kw_o, *vw;
    LAS const char *ka[4];
    LAS const char *va[2];
};
struct Run {
    unsigned off;
    unsigned tstep, rstride;
    int nt;
    float wl0, wstep;
    int thr_c, thr_w; bool causal_first, window_last;
    unsigned noff, nrstride, nqoff;
};

#define ATT_SB() __builtin_amdgcn_sched_barrier(0)
template <bool TWO> __device__ __forceinline__ void softmax_tiles(f32x16& sA, f32x16& sB, float wlA, float wlB, f32x16& o0, f32x16& o1, float& m, float& l) {
    float mt;
    if (TWO) { const float ra = rowmax16<2>(sA); const float rb = rowmax16_after(sB, ra); mt = max_raw(ra + wlA, rb + wlB); }
    else mt = rowmax16<1>(sA) + wlA;
    mt = swap_max(mt);
    if (__any(mt > m + THR)) {
        const float mn = fmaxf(m, mt), f = __builtin_amdgcn_exp2f(m - mn);
        o0 *= f; o1 *= f; l *= f; m = mn;
    }
    const float subA = m - wlA, subB = m - wlB;
    float ls = 0.f;
#pragma unroll
    for (int r = 0; r < 16; ++r) { sA[r] = __builtin_amdgcn_exp2f(sA[r] - subA); ls += sA[r]; }
    if (TWO) {
#pragma unroll
        for (int r = 0; r < 16; ++r) { sB[r] = __builtin_amdgcn_exp2f(sB[r] - subB); ls += sB[r]; }
    }
    l += ls;
    asm volatile("" : "+v"(l));
}
__device__ __forceinline__ void pack_p(const f32x16& s, bf16x8& pb0, bf16x8& pb1) {
    v4u pw0, pw1;
    pw0.x = cvt2(s[0], s[1]); pw0.y = cvt2(s[2], s[3]); pw0.z = cvt2(s[4], s[5]); pw0.w = cvt2(s[6], s[7]);
    pw1.x = cvt2(s[8], s[9]); pw1.y = cvt2(s[10], s[11]); pw1.z = cvt2(s[12], s[13]); pw1.w = cvt2(s[14], s[15]);
    pb0 = __builtin_bit_cast(bf16x8, pw0); pb1 = __builtin_bit_cast(bf16x8, pw1);
}
#define ATT_VF(lo, hi) ((bf16x8){lo[0], lo[1], lo[2], lo[3], hi[0], hi[1], hi[2], hi[3]})

__device__ __forceinline__ void load_q_off(bf16x8 (&qf)[4], const char* qbase  , unsigned off  ) {
#pragma unroll
    for (int ks = 0; ks < 4; ++ks) qf[ks] = *(const GAS bf16x8*)(qbase + 32 * ks + off);
}
__device__ __forceinline__ void run_tiles(const LaneC& C, const Run& R, const char* kbase, const char* vbase, const char* qbase, const bf16x8 (&qf)[4], bf16x8 (&qn)[4], v4u (&kst)[4], v4u (&vst)[4],
                                          const f32x16& Kc, f32x16& o0, f32x16& o1, float& m, float& l) {
    unsigned off = R.off;
#define ATT_ISSUE_K() do { _Pragma("unroll") for (int i_ = 0; i_ < 4; ++i_) kst[i_] = *(const GAS v4u*)(kbase + (size_t)(i_ * R.rstride) + off); } while (0)
#define ATT_ISSUE_V() do { _Pragma("unroll") for (int i_ = 0; i_ < 4; ++i_) vst[i_] = *(const GAS v4u*)(vbase + (size_t)(i_ * R.rstride) + off); off += R.tstep; } while (0)
#define ATT_PREF_KQ() do { _Pragma("unroll") for (int i_ = 0; i_ < 4; ++i_) kst[i_] = *(const GAS v4u*)(kbase + (size_t)(i_ * R.nrstride) + R.noff); load_q_off(qn, qbase, R.nqoff); } while (0)
#define ATT_PREF_V() do { _Pragma("unroll") for (int i_ = 0; i_ < 4; ++i_) vst[i_] = *(const GAS v4u*)(vbase + (size_t)(i_ * R.nrstride) + R.noff); } while (0)
#define ATT_COMMIT_K() do { *(LAS v4u*)(C.kw_e) = kst[0]; *(LAS v4u*)(C.kw_o) = kst[1]; *(LAS v4u*)(C.kw_e + 2048) = kst[2]; *(LAS v4u*)(C.kw_o + 2048) = kst[3]; } while (0)
#define ATT_COMMIT_V() do { _Pragma("unroll") for (int i_ = 0; i_ < 4; ++i_) *(LAS v4u*)(C.vw + 1024 * i_) = vst[i_]; } while (0)
    ATT_COMMIT_K(); ATT_COMMIT_V();
    if (R.nt > 1) { ATT_ISSUE_K(); ATT_ISSUE_V(); } else { ATT_PREF_KQ(); ATT_PREF_V(); }
    bf16x8 kf[4];
#pragma unroll
    for (int ks = 0; ks < 4; ++ks) kf[ks] = *(const LAS bf16x8*)C.ka[ks];
    ATT_SB();
    float wl = R.wl0;
    f32x16 s = Kc, sdummy;
#pragma unroll
    for (int ks = 0; ks < 4; ++ks) s = __builtin_amdgcn_mfma_f32_32x32x16_bf16(kf[ks], qf[ks], s, 0, 0, 0);
#define ATT_STEP(MORE, ISS, PREF) do { \
        const s16x4 a0 = vtr(C.va[0]), a1 = vtr(C.va[0] + 1024), a2 = vtr(C.va[0] + 2048), a3 = vtr(C.va[0] + 3072); \
        const s16x4 b0 = vtr(C.va[1]), b1 = vtr(C.va[1] + 1024), b2 = vtr(C.va[1] + 2048), b3 = vtr(C.va[1] + 3072); \
        ATT_SB(); \
        if (t == 0 && R.causal_first) { \
_Pragma("unroll") \
            for (int r = 0; r < 16; ++r) s[r] = (ATT_CROW(r) <= R.thr_c) ? s[r] : -INFINITY; \
        } \
        if (!(MORE) && R.window_last) { \
_Pragma("unroll") \
            for (int r = 0; r < 16; ++r) s[r] = (ATT_CROW(r) >= R.thr_w) ? s[r] : -INFINITY; \
        } \
        softmax_tiles<false>(s, sdummy, wl, 0.f, o0, o1, m, l); \
        bf16x8 pb0, pb1; pack_p(s, pb0, pb1); \
        o0 = __builtin_amdgcn_mfma_f32_32x32x16_bf16(ATT_VF(a0, a1), pb0, o0, 0, 0, 0); o1 = __builtin_amdgcn_mfma_f32_32x32x16_bf16(ATT_VF(b0, b1), pb0, o1, 0, 0, 0); \
        o0 = __builtin_amdgcn_mfma_f32_32x32x16_bf16(ATT_VF(a2, a3), pb1, o0, 0, 0, 0); o1 = __builtin_amdgcn_mfma_f32_32x32x16_bf16(ATT_VF(b2, b3), pb1, o1, 0, 0, 0); \
        ATT_SB(); \
        wl -= R.wstep; \
        if (MORE) { \
            ATT_COMMIT_K(); if (ISS) ATT_ISSUE_K(); if (PREF) ATT_PREF_KQ(); \
            ATT_COMMIT_V(); \
            if (ISS) ATT_ISSUE_V(); \
            if (PREF) ATT_PREF_V(); \
_Pragma("unroll") \
            for (int ks = 0; ks < 4; ++ks) kf[ks] = *(const LAS bf16x8*)C.ka[ks]; \
            ATT_SB(); \
            s = Kc; \
_Pragma("unroll") \
            for (int ks = 0; ks < 4; ++ks) s = __builtin_amdgcn_mfma_f32_32x32x16_bf16(kf[ks], qf[ks], s, 0, 0, 0); \
        } \
        ATT_SB(); } while (0)
    int t = 0;
#pragma nounroll
    for (; t + 2 < R.nt; ++t) ATT_STEP(1, 1, 0);
    if (t + 1 < R.nt) { ATT_STEP(1, 0, 1); ++t; }
    ATT_STEP(0, 0, 0);
#undef ATT_STEP
#undef ATT_ISSUE_K
#undef ATT_ISSUE_V
#undef ATT_PREF_KQ
#undef ATT_PREF_V
#undef ATT_COMMIT_K
#undef ATT_COMMIT_V
}

struct ShC { LAS char* kw; LAS char* vw; LAS const char* ka[4]; LAS const char* va[2]; };
__device__ __forceinline__ LAS float* st_o(LAS char* lds, int tau, int chunk) { return (LAS float*)(lds + ST_O + tau * 256 + (((chunk ^ tau ^ (tau >> 4)) & 15) << 4)); }
template <bool MERGE> __device__ __forceinline__ void state_put(LAS char* lds, int tau, int hi, const f32x16& o0, const f32x16& o1, float m, float l) {
    const float lt = swap_add(l);
    float fo = 1.f, fx = 0.f, lx = 0.f;
    LAS float* pm = (LAS float*)(lds + ST_M) + tau; LAS float* pl = (LAS float*)(lds + ST_L) + tau;
    if (MERGE) { const float mx = *pm; lx = *pl; const float mn = fmaxf(m, mx); fo = __builtin_amdgcn_exp2f(m - mn); fx = __builtin_amdgcn_exp2f(mx - mn); m = mn; }
#pragma unroll
    for (int d0 = 0; d0 < 2; ++d0)
#pragma unroll
        for (int g = 0; g < 4; ++g) { LAS f32x4* p = (LAS f32x4*)st_o(lds, tau, 8 * d0 + 2 * g + hi);
            f32x4 v = d0 == 0 ? (f32x4){o0[4 * g], o0[4 * g + 1], o0[4 * g + 2], o0[4 * g + 3]} : (f32x4){o1[4 * g], o1[4 * g + 1], o1[4 * g + 2], o1[4 * g + 3]};
            if (MERGE) { const f32x4 x = *p; v = v * fo + x * fx; }
            *p = v; }
    if (hi == 0) { *pm = m; *pl = lt * fo + lx * fx; }
}
__device__ __forceinline__ void state_store(LAS char* lds, int w, int lane, bf16* orow0  ) {
#pragma unroll
    for (int i = 0; i < 4; ++i) { const int tau = 32 * w + 8 * i + (lane >> 3), pc = lane & 7;
        const f32x4 a = *(LAS f32x4*)st_o(lds, tau, 2 * pc), b = *(LAS f32x4*)st_o(lds, tau, 2 * pc + 1);
        const float rl = 1.0f / *((LAS float*)(lds + ST_L) + tau);
        v4u o; o.x = cvt2(a[0] * rl, a[1] * rl); o.y = cvt2(a[2] * rl, a[3] * rl); o.z = cvt2(b[0] * rl, b[1] * rl); o.w = cvt2(b[2] * rl, b[3] * rl);
        *(GAS v4u*)(orow0 + (size_t)tau * D + 8 * pc) = o; }
}
__device__ __forceinline__ void load_q(bf16x8 (&qf)[4], const bf16* qrow  , int hi) {
#pragma unroll
    for (int ks = 0; ks < 4; ++ks) qf[ks] = *(const GAS bf16x8*)(qrow + 16 * ks + 8 * hi);
}

typedef _Float16 h16x4 __attribute__((ext_vector_type(4)));
__device__ __forceinline__ LAS h16x4* dst_slot(LAS char* lds, int tau, int slot) { return (LAS h16x4*)(lds + ST_O + tau * 128 + (((slot ^ tau ^ (tau >> 4)) & 15) << 3)); }
template <bool MERGE> __device__ __forceinline__ void dstate_put(LAS char* lds, int tau, int hi, const f32x16& o0, const f32x16& o1, float m, float l) {
    const float lt = swap_add(l);
    LAS float* pm = (LAS float*)(lds + ST_M) + tau; LAS float* pl = (LAS float*)(lds + ST_L) + tau;
    float a1 = 0.f, a2 = 1.f, ln = lt, mn = m;
    if (MERGE) { const float m1 = *pm, l1 = *pl; mn = fmaxf(m, m1); a1 = l1 * __builtin_amdgcn_exp2f(m1 - mn); a2 = __builtin_amdgcn_exp2f(m - mn); ln = a1 + lt * a2; }
    const float rn = 1.0f / ln; a1 *= rn; a2 *= rn;
#pragma unroll
    for (int d0 = 0; d0 < 2; ++d0)
#pragma unroll
        for (int g = 0; g < 4; ++g) { LAS h16x4* p = dst_slot(lds, tau, 8 * d0 + 2 * g + hi);
            f32x4 v = d0 == 0 ? (f32x4){o0[4 * g], o0[4 * g + 1], o0[4 * g + 2], o0[4 * g + 3]} : (f32x4){o1[4 * g], o1[4 * g + 1], o1[4 * g + 2], o1[4 * g + 3]};
            v = v * a2;
            if (MERGE) { const h16x4 x = *p; v = v + (f32x4){(float)x[0], (float)x[1], (float)x[2], (float)x[3]} * a1; }
            *p = (h16x4){(_Float16)v[0], (_Float16)v[1], (_Float16)v[2], (_Float16)v[3]}; }
    if (hi == 0) { *pm = mn; *pl = ln; }
}
__device__ __forceinline__ void dstate_store(LAS char* lds, int w, int lane, bf16* orow0  ) {
#pragma unroll
    for (int i = 0; i < 8; ++i) { const int tau = 64 * w + 8 * i + (lane >> 3), pc = lane & 7;
        const h16x4 a = *dst_slot(lds, tau, 2 * pc), b = *dst_slot(lds, tau, 2 * pc + 1);
        v4u o; o.x = cvt2((float)a[0], (float)a[1]); o.y = cvt2((float)a[2], (float)a[3]); o.z = cvt2((float)b[0], (float)b[1]); o.w = cvt2((float)b[2], (float)b[3]);
        *(GAS v4u*)(orow0 + (size_t)tau * D + 8 * pc) = o; }
}

__device__ __forceinline__ void attn_phase(Frame& F) {
    LAS char* lds = (LAS char*)F.lds;
    const int w = F.wave;
    gu32* qhead = F.ctl + CW_QUEUE;
    volatile LAS unsigned* uw = F.MISC + 16;
    const size_t KV_OFF = (size_t)M * D * 2;
    const int myx = (int)(xb_xcc_id() & 7u);
    const int qmax = F.local ? 1 : 8;
    int qsel = 0;
#define ATT_POP(dst_) do { dst_ = 0xffffffffu; while (qsel < qmax) { const int xq_ = (myx + qsel) & 7; const unsigned i_ = __hip_atomic_fetch_add(qhead + 64 * xq_, 1u, __ATOMIC_RELAXED, __HIP_MEMORY_SCOPE_AGENT); \
        if (i_ < (unsigned)UNITS_PER_XCD) { dst_ = (unsigned)xq_ * UNITS_PER_XCD + i_; break; } ++qsel; } } while (0)
    if (F.tid == 0) { unsigned u0_; ATT_POP(u0_); uw[0] = u0_; }
    const unsigned dummy_dst = (unsigned)__builtin_amdgcn_readfirstlane((int)(unsigned)(size_t)(lds + ST_DUMMY + 256 * w));
    if (w >= 4) __builtin_amdgcn_s_setprio(1);
    for (int it = 0;; ++it) {
        __syncthreads();
        const unsigned ucode = (unsigned)__builtin_amdgcn_readfirstlane((int)uw[it & 1]);
        if (ucode == 0xffffffffu) break;
        unsigned unext = 0xffffffffu;
        if (F.tid == 0) ATT_POP(unext);
        const int xq = (int)(ucode / UNITS_PER_XCD), ui = (int)(ucode % UNITS_PER_XCD);
        int ub, uj;
        if (ui < 272) { const int bq = ui / 68, j = ui % 68; ub = 4 * xq + bq; uj = (j < 20) ? (j / 5) * 8 + (j % 5) : 32 + (j - 20); }
        else { const int k = ui - 272, idx = k & 15; ub = 4 * xq + (idx >> 2); uj = (idx & 3) * 8 + 5 + (k >> 4); }
        const bool is_moba = uj < 32;
        f32x16 o0, o1; float m, l; bf16x8 qf[4];
        int tl_ = F.tid; asm volatile("" : "+v"(tl_));
        const int lane = tl_ & 63, q = lane & 31, hi = lane >> 5, srow = lane >> 3, sch = lane & 7, tid512 = tl_;
        const int Lq = q - 4 * hi;
        f32x16 cr;
#pragma unroll
        for (int r = 0; r < 16; ++r) cr[r] = (float)ATT_CROW(r);
        if (is_moba) {
            ShC S;
            { const int row = tid512 >> 3, ch = tid512 & 7;
              S.kw = lds + row * 128 + ((ch ^ ((row >> 1) & 7)) << 4); S.vw = lds + 8192 + row * 128 + ((ch ^ (((row >> 1) & 1) << 2)) << 4);
#pragma unroll
              for (int ks = 0; ks < 4; ++ks) S.ka[ks] = lds + q * 128 + (((2 * ks + hi) ^ ((q >> 1) & 7)) << 4);
              const int q4 = (lane & 15) >> 2, p = lane & 3, blk = (lane >> 4) & 1, swz = ((q4 >> 1) & 1) << 6;
              S.va[0] = lds + 8192 + (4 * hi + q4) * 128 + swz + 32 * blk + 8 * p; S.va[1] = lds + 8192 + (4 * hi + q4) * 128 + (64 ^ swz) + 32 * blk + 8 * p; }
            const int n = 7 - (uj & 7), b = ub, hb = uj >> 3, hcol = (NHA + hb) * 64;
            const float sl2 = __builtin_amdgcn_exp2f(-2.0f * (float)(hb + 1)) * LOG2E;
            const f32x16 Kc = cr * sl2;
            const size_t row0 = (size_t)b * SEQ + 256 * n;
            load_q(qf, F.QB + (row0 + 32 * w + q) * D + hcol, hi);
            unsigned selmask = (1u << n) - 1u;
            if (n > 3) {
                const int rho = q, mrow = (rho & 3) + 4 * ((rho >> 3) & 1), part = rho >> 4;
                f32x16 g = (f32x16){0.f, 0.f, 0.f, 0.f, 0.f, 0.f, 0.f, 0.f, 0.f, 0.f, 0.f, 0.f, 0.f, 0.f, 0.f, 0.f};
                const float* ksrow = F.KS + (size_t)(b * 8 + mrow) * 256 + hb * 64;
#pragma unroll
                for (int ks = 0; ks < 4; ++ks) { const f32x4 x0 = *(const GAS f32x4*)(ksrow + 16 * ks + 8 * hi), x1 = *(const GAS f32x4*)(ksrow + 16 * ks + 8 * hi + 4);
                    const float xv[8] = {x0[0], x0[1], x0[2], x0[3], x1[0], x1[1], x1[2], x1[3]}; unsigned pk[4];
#pragma unroll
                    for (int e = 0; e < 4; ++e) { float a0 = xv[2 * e], a1 = xv[2 * e + 1];
                        const unsigned hp = cvt2(a0, a1);
                        if (part) { a0 -= __uint_as_float(hp << 16); a1 -= __uint_as_float(hp & 0xffff0000u); pk[e] = cvt2(a0, a1); } else pk[e] = hp; }
                    const v4u pv = {pk[0], pk[1], pk[2], pk[3]};
                    g = __builtin_amdgcn_mfma_f32_32x32x16_bf16(__builtin_bit_cast(bf16x8, pv), qf[ks], g, 0, 0, 0); }
                float gv[8];
#pragma unroll
                for (int e = 0; e < 8; ++e) gv[e] = g[e] + g[e + 8];
                selmask = 0u;
#pragma unroll
                for (int e = 0; e < 8; ++e) { int better = 0;
#pragma unroll
                    for (int e2 = 0; e2 < 8; ++e2) if (e2 != e) better += (e2 < n && (gv[e2] > gv[e] || (gv[e2] == gv[e] && e2 < e))) ? 1 : 0;
                    if (e < n && better < 3) selmask |= 1u << e; }
            }
            o0 = (f32x16){0.f, 0.f, 0.f, 0.f, 0.f, 0.f, 0.f, 0.f, 0.f, 0.f, 0.f, 0.f, 0.f, 0.f, 0.f, 0.f}; o1 = o0; m = -1e30f; l = 0.f;
            const int NR = 4 * (n + 1);
            const bf16* kbase = F.KB + (((size_t)b * 16 + (hcol >> 6)) * SEQ + (tid512 >> 3)) * HD + 8 * (tid512 & 7);
            v4u kr0, vr0, kr1, vr1, kr2, vr2, kr3, vr3;
#define SH_ISSUE(r_, KR, VR) do { const size_t off_ = (size_t)(256 * (n - ((r_) >> 2)) + 64 * (3 - ((r_) & 3))) * HD; KR = *(const GAS v4u*)(kbase + off_); VR = *(const GAS v4u*)((const char*)(kbase + off_) + KV_OFF); } while (0)
#define SH_COMMIT(buf_, KR, VR) do { *(LAS v4u*)(S.kw + (buf_) * 16384) = KR; *(LAS v4u*)(S.vw + (buf_) * 16384) = VR; } while (0)
#define SH_BARRIER() do { asm volatile("s_waitcnt lgkmcnt(0)" ::: "memory"); __builtin_amdgcn_s_barrier(); asm volatile("" ::: "memory"); } while (0)
            SH_ISSUE(0, kr0, vr0); SH_ISSUE(1, kr1, vr1); SH_ISSUE(2, kr2, vr2); SH_ISSUE(3, kr3, vr3);
            SH_COMMIT(0, kr0, vr0); if (NR > 4) SH_ISSUE(4, kr0, vr0);
            SH_BARRIER();
#define SH_ROUND(RR, KRN, VRN) do { const int r = (RR); \
                const int bi = r >> 2, jj = 3 - (r & 3), bufo = (r & 1) * 16384; \
                const int DA = 256 * bi + 32 * w - 64 * jj, DB = DA - 32; \
                const bool lane_on = (bi == 0) ? true : (((selmask >> (n - bi)) & 1u) != 0u); \
                if (DA >= 0 && __any(lane_on)) { \
                    bf16x8 kfa[4], kfb[4]; \
_Pragma("unroll") \
                    for (int ks = 0; ks < 4; ++ks) { kfa[ks] = *(const LAS bf16x8*)(S.ka[ks] + bufo); kfb[ks] = *(const LAS bf16x8*)(S.ka[ks] + bufo + 4096); } \
                    ATT_SB(); \
                    f32x16 sA = Kc, sB = Kc; \
_Pragma("unroll") \
                    for (int ks = 0; ks < 4; ++ks) { sA = __builtin_amdgcn_mfma_f32_32x32x16_bf16(kfa[ks], qf[ks], sA, 0, 0, 0); sB = __builtin_amdgcn_mfma_f32_32x32x16_bf16(kfb[ks], qf[ks], sB, 0, 0, 0); } \
                    ATT_SB(); \
                    const float wlA = lane_on ? -(sl2 * (float)(DA + Lq)) : -INFINITY, wlB = (lane_on && DB >= 0) ? -(sl2 * (float)(DB + Lq)) : -INFINITY; \
                    if (bi == 0 && DA == 0) { \
_Pragma("unroll") \
                        for (int rr = 0; rr < 16; ++rr) sA[rr] = (ATT_CROW(rr) <= Lq) ? sA[rr] : -INFINITY; \
                    } \
                    if (bi == 0 && DB == 0) { \
_Pragma("unroll") \
                        for (int rr = 0; rr < 16; ++rr) sB[rr] = (ATT_CROW(rr) <= Lq) ? sB[rr] : -INFINITY; \
                    } \
                    softmax_tiles<true>(sA, sB, wlA, wlB, o0, o1, m, l); \
                    bf16x8 pa0, pa1, pb0, pb1; pack_p(sA, pa0, pa1); pack_p(sB, pb0, pb1); \
_Pragma("unroll") \
                    for (int d0 = 0; d0 < 2; ++d0) { LAS const char* vp_ = S.va[d0] + bufo; \
                        const s16x4 a0 = vtr(vp_), a1 = vtr(vp_ + 1024), a2 = vtr(vp_ + 2048), a3 = vtr(vp_ + 3072); \
                        const s16x4 b0 = vtr(vp_ + 4096), b1 = vtr(vp_ + 5120), b2 = vtr(vp_ + 6144), b3 = vtr(vp_ + 7168); \
                        if (d0 == 0) { o0 = __builtin_amdgcn_mfma_f32_32x32x16_bf16(ATT_VF(a0, a1), pa0, o0, 0, 0, 0); o0 = __builtin_amdgcn_mfma_f32_32x32x16_bf16(ATT_VF(a2, a3), pa1, o0, 0, 0, 0); \
                                       o0 = __builtin_amdgcn_mfma_f32_32x32x16_bf16(ATT_VF(b0, b1), pb0, o0, 0, 0, 0); o0 = __builtin_amdgcn_mfma_f32_32x32x16_bf16(ATT_VF(b2, b3), pb1, o0, 0, 0, 0); } \
                        else         { o1 = __builtin_amdgcn_mfma_f32_32x32x16_bf16(ATT_VF(a0, a1), pa0, o1, 0, 0, 0); o1 = __builtin_amdgcn_mfma_f32_32x32x16_bf16(ATT_VF(a2, a3), pa1, o1, 0, 0, 0); \
                                       o1 = __builtin_amdgcn_mfma_f32_32x32x16_bf16(ATT_VF(b0, b1), pb0, o1, 0, 0, 0); o1 = __builtin_amdgcn_mfma_f32_32x32x16_bf16(ATT_VF(b2, b3), pb1, o1, 0, 0, 0); } } \
                } \
                if (r + 1 < NR) { SH_COMMIT((r + 1) & 1, KRN, VRN); if (r + 5 < NR) SH_ISSUE(r + 5, KRN, VRN); } \
                SH_BARRIER(); } while (0)
#pragma nounroll
            for (int r0 = 0; r0 < NR; r0 += 4) { SH_ROUND(r0, kr1, vr1); SH_ROUND(r0 + 1, kr2, vr2); SH_ROUND(r0 + 2, kr3, vr3); SH_ROUND(r0 + 3, kr0, vr0); }
#undef SH_ROUND
#undef SH_ISSUE
#undef SH_COMMIT
#undef SH_BARRIER
            state_put<false>(lds, 32 * w + q, hi, o0, o1, m, l);
            state_store(lds, w, lane, F.OB + row0 * D + hcol);
        } else {
            LaneC C;
            { LAS char* kb = lds + w * 8192; LAS char* vb = kb + 4096; const int x0 = srow >> 1;
              C.kw_e = kb + srow * 128 + ((sch ^ x0) << 4); C.kw_o = kb + (srow + 8) * 128 + ((sch ^ (x0 + 4)) << 4); C.vw = vb + srow * 128 + ((sch ^ ((x0 & 1) << 2)) << 4);
#pragma unroll
              for (int ks = 0; ks < 4; ++ks) C.ka[ks] = kb + q * 128 + (((2 * ks + hi) ^ ((q >> 1) & 7)) << 4);
              const int q4 = (lane & 15) >> 2, p = lane & 3, blk = (lane >> 4) & 1, swz = ((q4 >> 1) & 1) << 6;
              C.va[0] = vb + (4 * hi + q4) * 128 + swz + 32 * blk + 8 * p; C.va[1] = vb + (4 * hi + q4) * 128 + (64 ^ swz) + 32 * blk + 8 * p; }
            const int u2 = uj - 32, c = 3 - (u2 & 3), b = ub, h = u2 >> 2, hcol = h * 64;
            const float sl2 = __builtin_amdgcn_exp2f(-0.5f * (float)(h + h / 3 + 1)) * LOG2E;
            const size_t brow = (size_t)b * SEQ; const int T0 = 512 * c;
#define DIL_PARAMS(rr, d_, ibase_, kcls_, nt_, win_) \
            const int d_ = ((rr) < 2) ? 1 : ((rr) < 4 ? 4 : 16); int ibase_, kcls_, nt_; bool win_; \
            if ((rr) < 2) { ibase_ = T0 + 64 * w + 32 * ((rr) & 1); kcls_ = 0; nt_ = min(5, ibase_ / 32 + 1); win_ = (nt_ == 5); } \
            else if ((rr) < 4) { ibase_ = T0 / 4 + 64 * (w & 1) + 32 * ((rr) & 1); kcls_ = w >> 1; nt_ = min(5, ibase_ / 32 + 1); win_ = (nt_ == 5); } \
            else { ibase_ = T0 / 16; kcls_ = 2 * w + ((rr) & 1); nt_ = c + 1; win_ = false; }
#define DIL_RO(r_) (((r_) < 2) ? (r_) + 4 : (((r_) < 4) ? (r_) : (r_) - 4))
#define DIL_KOFF(d_, ibase_, kcls_) ((unsigned)((((b * 16 + h) * SEQ) + (d_) * ((ibase_) + srow) + (kcls_)) * (HD * 2) + 16 * sch))
#define DIL_QOFF(d_, ibase_, kcls_) ((unsigned)(((int)brow + (d_) * ((ibase_) + q) + (kcls_)) * (D * 2) + hcol * 2 + 16 * hi))
            const char* kbase = (const char*)F.KB; const char* vbase = kbase + KV_OFF; const char* qbase = (const char*)F.QB;
            bf16x8 qn[4]; v4u kst[4], vst[4];
            { DIL_PARAMS(DIL_RO(0), d0_, ib0_, kc0_, nt0_, win0_) (void)nt0_; (void)win0_;
              const unsigned ko_ = DIL_KOFF(d0_, ib0_, kc0_), rs0_ = 8u * d0_ * HD * 2;
#pragma unroll
              for (int i_ = 0; i_ < 4; ++i_) kst[i_] = *(const GAS v4u*)(kbase + (size_t)(i_ * rs0_) + ko_);
              load_q_off(qn, qbase, DIL_QOFF(d0_, ib0_, kc0_));
#pragma unroll
              for (int i_ = 0; i_ < 4; ++i_) vst[i_] = *(const GAS v4u*)(vbase + (size_t)(i_ * rs0_) + ko_); }
#pragma unroll
            for (int r = 0; r < 6; ++r) {
                const int ro = DIL_RO(r);
                DIL_PARAMS(ro, d, ibase, kcls, nt, win)
                const int rn = DIL_RO((r < 5) ? r + 1 : 5);
                DIL_PARAMS(rn, dn, ibn, kcn, ntn, winn) (void)ntn; (void)winn;
                const int sub = ro & 1;
                const int tau = (ro < 2) ? 64 * w + 32 * sub + q : (ro < 4 ? 4 * (64 * (w & 1) + 32 * sub + q) + kcls : 16 * q + kcls);
                const float sl2d = sl2 * (float)d;
#pragma unroll
                for (int ks = 0; ks < 4; ++ks) qf[ks] = qn[ks];
                o0 = (f32x16){0.f, 0.f, 0.f, 0.f, 0.f, 0.f, 0.f, 0.f, 0.f, 0.f, 0.f, 0.f, 0.f, 0.f, 0.f, 0.f}; o1 = o0; m = -1e30f; l = 0.f;
                const f32x16 Kc = cr * sl2d;
                Run R;
                R.tstep = (unsigned)(-(32 * d * HD * 2)); R.rstride = 8u * d * HD * 2; R.nt = nt;
                R.off = DIL_KOFF(d, ibase, kcls) + R.tstep;
                R.wl0 = -(sl2d * (float)Lq); R.wstep = sl2d * 32.f;
                R.thr_c = Lq; R.thr_w = Lq; R.causal_first = true; R.window_last = win;
                R.noff = DIL_KOFF(dn, ibn, kcn); R.nrstride = 8u * dn * HD * 2; R.nqoff = DIL_QOFF(dn, ibn, kcn);
                run_tiles(C, R, kbase, vbase, qbase, qf, qn, kst, vst, Kc, o0, o1, m, l);
                if (r < 2) dstate_put<false>(lds, tau, hi, o0, o1, m, l); else dstate_put<true>(lds, tau, hi, o0, o1, m, l);
                if (r == 1 || r == 3) { asm volatile("s_waitcnt lgkmcnt(0)" ::: "memory"); __builtin_amdgcn_s_barrier(); asm volatile("" ::: "memory"); }
            }
#undef DIL_PARAMS
#undef DIL_KOFF
#undef DIL_RO
#undef DIL_QOFF
            dstate_store(lds, w, lane, F.OB + (brow + T0) * D + hcol);
        }
        if (F.tid == 0) uw[(it + 1) & 1] = unext;
    }
    __builtin_amdgcn_s_setprio(0);
}
#undef ATT_POP
#undef ATT_CROW
#undef ATT_SB
#undef ATT_VF
}
struct Args { const float* in[15]; float* out; unsigned char* ws; };
__global__ void __launch_bounds__(NWAVES * 64, 2) fwd_kernel(Args args) {
    extern __shared__ __attribute__((aligned(16))) unsigned char lds[];
    Frame F;
    F.lds = (LAS unsigned char*)lds;
    F.MISC = (volatile LAS unsigned*)(F.lds + MISC_OFF);
    F.tid = threadIdx.x; F.lane = F.tid & 63; F.wave = __builtin_amdgcn_readfirstlane(F.tid >> 6);
    F.G = gridDim.x; { const int bx = blockIdx.x; F.vcu = (F.G % 8 == 0) ? (bx % 8) * (F.G / 8) + bx / 8 : bx; }
    unsigned char* ws = args.ws;
    F.ctl = (gu32*)(ws + WS_CTL);
    F.x = args.in[0]; F.g1w = args.in[1]; F.u1w = args.in[2]; F.d1w = args.in[3]; F.ln1g = args.in[4]; F.ln1b = args.in[5]; F.win = args.in[6]; F.wout = args.in[7];
    F.ln2g = args.in[8]; F.ln2b = args.in[9]; F.g2w = args.in[10]; F.u2w = args.in[11]; F.d2w = args.in[12]; F.ln3g = args.in[13]; F.ln3b = args.in[14]; F.out = args.out;
    F.W1T = (bf16*)(ws + WS_W1T); F.W2T = (bf16*)(ws + WS_W2T); F.WINT = (bf16*)(ws + WS_WINT); F.WOT = (bf16*)(ws + WS_WOT); F.W3T = (bf16*)(ws + WS_W3T); F.W4T = (bf16*)(ws + WS_W4T);
    F.AB = (bf16*)(ws + WS_AB); F.YH = (unsigned short*)(ws + WS_YH); F.HB = (bf16*)(ws + WS_R1);
    F.QB = (bf16*)(ws + WS_OB); F.KB = (bf16*)args.out; F.VB = F.KB + (size_t)M * D;
    F.OB = (bf16*)(ws + WS_OB); F.KS = (float*)(ws + WS_KS);
    F.CSIN = (float*)(ws + WS_VEC); F.BWIN = F.CSIN + NQKV; F.CS3 = F.BWIN + NQKV; F.BW3 = F.CS3 + NGU;
    F.PS1 = (pg8::f32x2v*)(ws + WS_PS); F.PS2 = F.PS1 + (size_t)M * 4; F.PS3 = F.PS2 + (size_t)M * 4; F.RS1 = (pg8::f32x2v*)(ws + WS_RS); F.RS2 = F.RS1 + M;
    for (int u = F.tid; u < (LDS_BYTES - LDSCTL_OFF) / 4; u += NWAVES * 64) ((LAS unsigned*)(F.lds + LDSCTL_OFF))[u] = 0u;
    __syncthreads();
    XcdBarrier bar = xcd_barrier_post((unsigned*)(F.ctl + CW_BAR), F.MISC + 8);
    if (F.tid == 0 && (bar.x != (blockIdx.x & 7u) || F.G != 256)) (void)xb_add((unsigned*)(F.ctl + CW_BAD), 1u);
    F.local = 0;
    gu32* lcnt = F.ctl + CW_LBAR + 64 * (blockIdx.x & 7u);

    p0_prologue(F);
    xcd_barrier(bar);
    F.local = __builtin_amdgcn_readfirstlane((int)(xb_ld((unsigned*)(F.ctl + CW_BAD)) == 0u));
    if (F.local) {
        for (unsigned i_ = 0; i_ < (blockIdx.x & 7u) * XCD_SKEW; ++i_) __builtin_amdgcn_s_sleep(127);
    }
    { pg8::Gemm g{F.AB, F.W1T, M, NGU, D}; pg8::StaticOrder S; S.init(M, NGU, F.G, (int)blockIdx.x);
      pg8::EpiSwiGLU<false> E{F.HB, FF, pg8::LnFold{(PG8_LAS const pg8::f32x2v*)nullptr, nullptr, nullptr}};
      pg8::gemm_phase<pg8::EpiSwiGLU<false>, pg8::StaticOrder, true, PG8_SP2>(F.lds + RING_OFF, g, S, E); }
    seam(bar, F.local, lcnt, 1u * 32u);
    { pg8::Gemm g{F.HB, F.W2T, M, D, FF}; pg8::StaticOrder S; S.init(M, D, F.G, (int)blockIdx.x);
      pg8::EpiRes<false> E{F.x, F.AB, F.YH, F.PS1, (PG8_LAS const pg8::f32x2v*)nullptr, nullptr, nullptr, ALPHA, 0.5f};
      pg8::gemm_phase<pg8::EpiRes<false>, pg8::StaticOrder, true, PG8_SP2>(F.lds + RING_OFF, g, S, E); }
    seam(bar, F.local, lcnt, 2u * 32u);
    { pg8::Gemm g{F.AB, F.WINT, M, NQKV, D}; pg8::StaticOrder S; S.init(M, NQKV, F.G, (int)blockIdx.x);
      { pg8::Unit u0; S.next(0, u0); fill_row_stats(F, F.PS1, u0.pm); }
      pg8::EpiQKV E{F.QB, F.KB, (size_t)M * D, QSCALE, F.KS, pg8::LnFold{(PG8_LAS const pg8::f32x2v*)(F.lds + RSL_OFF), F.CSIN, F.BWIN}};
      pg8::gemm_phase<pg8::EpiQKV, pg8::StaticOrder, true, PG8_SP2>(F.lds + RING_OFF, g, S, E); }
    seam(bar, F.local, lcnt, 3u * 32u);
    att::attn_phase(F);
    seam(bar, F.local, lcnt, 4u * 32u);
    { pg8::Gemm g{F.OB, F.WOT, M, D, D}; pg8::StaticOrder S; S.init(M, D, F.G, (int)blockIdx.x);
      { pg8::Unit u0; S.next(0, u0); fill_row_stats(F, F.PS1, u0.pm); }
      pg8::EpiRes<true> E{nullptr, F.AB, F.YH, F.PS2, (PG8_LAS const pg8::f32x2v*)(F.lds + RSL_OFF), F.ln1g, F.ln1b, ALPHA, 1.0f};
      pg8::gemm_phase<pg8::EpiRes<true>, pg8::StaticOrder, true, PG8_SP2>(F.lds + RING_OFF, g, S, E); }
    seam(bar, F.local, lcnt, 5u * 32u);
    { pg8::Gemm g{F.AB, F.W3T, M, NGU, D}; pg8::StaticOrder S; S.init(M, NGU, F.G, (int)blockIdx.x);
      { pg8::Unit u0; S.next(0, u0); fill_row_stats(F, F.PS2, u0.pm); }
      pg8::EpiSwiGLU<true> E{F.HB, FF, pg8::LnFold{(PG8_LAS const pg8::f32x2v*)(F.lds + RSL_OFF), F.CS3, F.BW3}};
      pg8::gemm_phase<pg8::EpiSwiGLU<true>, pg8::StaticOrder, true, PG8_SP2>(F.lds + RING_OFF, g, S, E); }
    seam(bar, F.local, lcnt, 6u * 32u);
    { pg8::Gemm g{F.HB, F.W4T, M, D, FF}; pg8::StaticOrder S; S.init(M, D, F.G, (int)blockIdx.x);
      { pg8::Unit u0; S.next(0, u0); fill_row_stats(F, F.PS2, u0.pm); }
      pg8::EpiRes<true> E{nullptr, nullptr, F.YH, F.PS3, (PG8_LAS const pg8::f32x2v*)(F.lds + RSL_OFF), F.ln2g, F.ln2b, ALPHA, 0.5f};
      pg8::gemm_phase<pg8::EpiRes<true>, pg8::StaticOrder, true, PG8_SP2>(F.lds + RING_OFF, g, S, E); }
    xcd_barrier(bar);
    final_phase(F);
}

extern "C" void kernel_launch(void* const* d_in, const int* in_sizes, int n_in, void* d_out, int out_size, void* d_ws, size_t ws_size, hipStream_t stream) {
    static int grid = 0;
    if (grid == 0) {
        if (n_in != 15 || in_sizes[0] != M * D || out_size != M * D || ws_size < WS_END) { fprintf(stderr, "kernel_launch: shape/workspace mismatch (n_in %d, in0 %d, out %d, ws %zu)\n", n_in, n_in > 0 ? in_sizes[0] : -1, out_size, ws_size); grid = -1; return; }
        int dev = 0, cus = 0, per_cu = 0;
        if (hipGetDevice(&dev) != hipSuccess || hipDeviceGetAttribute(&cus, hipDeviceAttributeMultiprocessorCount, dev) != hipSuccess) { grid = -1; return; }
        if (hipFuncSetAttribute((const void*)fwd_kernel, hipFuncAttributeMaxDynamicSharedMemorySize, LDS_BYTES) != hipSuccess) { fprintf(stderr, "kernel_launch: hipFuncSetAttribute failed\n"); grid = -1; return; }
        if (hipOccupancyMaxActiveBlocksPerMultiprocessor(&per_cu, (const void*)fwd_kernel, NWAVES * 64, LDS_BYTES) != hipSuccess || per_cu < 1) { fprintf(stderr, "kernel_launch: occupancy query reports %d\n", per_cu); }
        (void)hipGetLastError();
        grid = cus;
    }
    if (grid < 0) return;
    if (hipMemsetAsync((char*)d_ws + WS_CTL, 0, CTL_ZERO_BYTES, stream) != hipSuccess) return;
    Args a{};
    for (int i = 0; i < 15; ++i) a.in[i] = (const float*)d_in[i];
    a.out = (float*)d_out; a.ws = (unsigned char*)d_ws;
    hipLaunchKernelGGL(fwd_kernel, dim3(grid), dim3(NWAVES * 64), LDS_BYTES, stream, a);
}
```

```cpp
#define XCD_SKEW 1u
#include <hip/hip_runtime.h>
#include <cstdio>
#include <cstdint>
#include <cmath>
namespace pg8 {
#define PG8_LAS __attribute__((address_space(3)))
typedef unsigned short bf16_t;
typedef short bf16x8 __attribute__((ext_vector_type(8)));
typedef float f32x4 __attribute__((ext_vector_type(4)));
typedef unsigned u32x4 __attribute__((ext_vector_type(4)));
constexpr int BM = 256, BK = 64, HALF = 128, HTB = HALF * BK * 2  , STAGE_BYTES = 8 * HTB, NXCD = 8, WGM = 8;

__host__ __device__ __forceinline__ int lds_byte(int r, int c) { const int st = (r >> 4) * 2 + (c >> 5), rr = r & 15, cc = c & 31, ob = rr * 64 + cc * 2; return st * 1024 + (ob ^ (((ob >> 9) & 1) << 5)); }
__host__ __device__ __forceinline__ void stage_rc(int b, int& R, int& C) { const int st = b / 1024, sb = b % 1024, swz = sb ^ (((sb >> 9) & 1) << 5); R = (st >> 1) * 16 + swz / 64; C = (st & 1) * 32 + (swz % 64) / 2; }
__host__ __device__ __forceinline__ int perm32(int rho) { const int n = rho >> 4, i = rho & 15; return 8 * (i >> 2) + 4 * n + (i & 3); }

struct Unit { int pm, pn; };
struct Gemm { const bf16_t* A; const bf16_t* Bt; int M, N, K; };

struct StaticOrder {
    int nM, nN, nwg, G, c;
    __host__ __device__ void init(int M, int N, int G_, int c_) { nM = M / BM; nN = N / BM; nwg = nM * nN; G = G_; c = c_; }
    __host__ __device__ __forceinline__ bool next(int i, Unit& u) const {
        const long L = (long)i * G + c; if (L >= nwg) return false;
        int wgid = (int)L; { const int q = nwg / NXCD, r = nwg % NXCD, xcd = wgid % NXCD, off = wgid / NXCD; wgid = (xcd < r ? xcd * (q + 1) : r * (q + 1) + (xcd - r) * q) + off; }
        const int nig = WGM * nN, gid = wgid / nig, fm = gid * WGM, gsz = (nM - fm) < WGM ? (nM - fm) : WGM;
        u.pm = fm + ((wgid % nig) % gsz); u.pn = (wgid % nig) / gsz; return true;
    }
    __device__ __forceinline__ void a_ready(const Unit&) const {}
    __device__ __forceinline__ void done(const Unit&) const {}
};

__device__ __forceinline__ unsigned cvt_pk_bf16(float lo, float hi) { unsigned r; asm volatile("v_cvt_pk_bf16_f32 %0, %1, %2" : "=v"(r) : "v"(lo), "v"(hi)); return r; }
typedef float f32x2 __attribute__((ext_vector_type(2)));
typedef float f32x2v __attribute__((ext_vector_type(2)));
typedef _Float16 h16x2 __attribute__((ext_vector_type(2)));
__device__ __forceinline__ unsigned cvt_pk_f16(float lo, float hi) { f32x2v v = {lo, hi}; return __builtin_bit_cast(unsigned, __builtin_convertvector(v, h16x2)); }
__device__ __forceinline__ f32x2v unpk_f16(unsigned w) { const h16x2 h = __builtin_bit_cast(h16x2, w); return (f32x2v){(float)h[0], (float)h[1]}; }
struct LnFold { PG8_LAS const f32x2v* RS; const float* cs; const float* bw; };

template <bool FOLD> struct EpiSwiGLU {
    static constexpr bool PERM = true, AFTER_DRAIN = false; static constexpr int NVMEM = 8;
    bf16_t* H; int ldh; LnFold lf;
    __device__ __forceinline__ static float silu_mul(float g, float u) { const float e = __builtin_amdgcn_exp2f(g * -1.4426950408889634f); return g * __builtin_amdgcn_rcpf(1.0f + e) * u; }
    __device__ __forceinline__ void operator()(const f32x4 (&acc)[2][2][4][2], const Unit& u, int wr_, int wc_, int fr_, int fq_, PG8_LAS unsigned char*, int tid) const {
        int t_ = tid; asm volatile("" : "+v"(t_));
        const int lane_ = t_ & 63, wid_ = __builtin_amdgcn_readfirstlane(t_ >> 6), wr = wid_ >> 2, wc = wid_ & 3, fr = lane_ & 15, fq = lane_ >> 4; (void)wr_; (void)wc_; (void)fr_; (void)fq_;
        const int row0 = u.pm * BM + wr * 64 + fr, col0 = u.pn * HALF + wc * 32 + 8 * fq, bcol0 = u.pn * BM + wc * 32 + 8 * fq;
        f32x4 cs[2][2], bw[2][2];
        if (FOLD) {
#pragma unroll
            for (int bj = 0; bj < 2; ++bj)
#pragma unroll
                for (int n = 0; n < 2; ++n) { cs[bj][n] = *(const f32x4*)(lf.cs + bcol0 + bj * HALF + 4 * n); bw[bj][n] = *(const f32x4*)(lf.bw + bcol0 + bj * HALF + 4 * n); }
        }
#pragma unroll
        for (int ai = 0; ai < 2; ++ai)
#pragma unroll
            for (int m = 0; m < 4; ++m) { const int row = row0 + ai * HALF + m * 16; bf16_t* rowp = H + (size_t)row * ldh + col0;
                f32x4 g0 = acc[ai][0][m][0], g1 = acc[ai][0][m][1], u0 = acc[ai][1][m][0], u1 = acc[ai][1][m][1];
                if (FOLD) { const f32x2v rs = lf.RS[((u.pm >> 3) & 3) * BM + (row & (BM - 1))];
                    g0 = (g0 - cs[0][0] * rs.x) * rs.y + bw[0][0]; g1 = (g1 - cs[0][1] * rs.x) * rs.y + bw[0][1];
                    u0 = (u0 - cs[1][0] * rs.x) * rs.y + bw[1][0]; u1 = (u1 - cs[1][1] * rs.x) * rs.y + bw[1][1]; }
                u32x4 w; w.x = cvt_pk_bf16(silu_mul(g0[0], u0[0]), silu_mul(g0[1], u0[1])); w.y = cvt_pk_bf16(silu_mul(g0[2], u0[2]), silu_mul(g0[3], u0[3]));
                w.z = cvt_pk_bf16(silu_mul(g1[0], u1[0]), silu_mul(g1[1], u1[1])); w.w = cvt_pk_bf16(silu_mul(g1[2], u1[2]), silu_mul(g1[3], u1[3]));
                *(u32x4*)rowp = w; }
    }
};
__device__ __forceinline__ f32x2v unpk_bf16(unsigned w) { return (f32x2v){__uint_as_float(w << 16), __uint_as_float(w & 0xffff0000u)}; }
template <bool RES_LN, bool IN_BF = false, bool OUT_BF = false> struct EpiRes {
    static constexpr bool PERM = true, AFTER_DRAIN = false; static constexpr int NVMEM = 16;
    const float* X; bf16_t* YB; unsigned short* YH; f32x2v* PS; PG8_LAS const f32x2v* RS  ; const float* g; const float* b; float alpha, beta;
    __device__ __forceinline__ void operator()(const f32x4 (&acc)[2][2][4][2], const Unit& u, int wr_, int wc_, int fr_, int fq_, PG8_LAS unsigned char* xlds, int tid) const {
        int t_ = tid; asm volatile("" : "+v"(t_));
        const int lane_ = t_ & 63, wid_ = __builtin_amdgcn_readfirstlane(t_ >> 6), wr = wid_ >> 2, wc = wid_ & 3, fr = lane_ & 15, fq = lane_ >> 4; (void)wr_; (void)wc_; (void)fr_; (void)fq_;
        const int row0 = u.pm * BM + wr * 64 + fr, col0 = u.pn * BM + wc * 32 + 8 * fq;
        f32x4 gg[2][2], bb[2][2];
        if (RES_LN) {
#pragma unroll
            for (int bj = 0; bj < 2; ++bj)
#pragma unroll
                for (int n = 0; n < 2; ++n) { gg[bj][n] = *(const f32x4*)(g + col0 + bj * HALF + 4 * n); bb[bj][n] = *(const f32x4*)(b + col0 + bj * HALF + 4 * n); }
        }
        PG8_LAS f32x2v* P = (PG8_LAS f32x2v*)xlds;
#pragma unroll
        for (int ai = 0; ai < 2; ++ai)
#pragma unroll
            for (int m = 0; m < 4; ++m) { const int row = row0 + ai * HALF + m * 16; const size_t off = (size_t)row * 1024 + col0;
                f32x4 r[2][2];
                if (RES_LN) { const f32x2v rs = RS[((u.pm >> 3) & 3) * BM + (row & (BM - 1))];
#pragma unroll
                    for (int bj = 0; bj < 2; ++bj) { const u32x4 hw = *(const u32x4*)(YH + off + bj * HALF);
                        const f32x2v a0 = IN_BF ? unpk_bf16(hw.x) : unpk_f16(hw.x), a1 = IN_BF ? unpk_bf16(hw.y) : unpk_f16(hw.y), a2 = IN_BF ? unpk_bf16(hw.z) : unpk_f16(hw.z), a3 = IN_BF ? unpk_bf16(hw.w) : unpk_f16(hw.w);
                        r[bj][0] = ((f32x4){a0.x, a0.y, a1.x, a1.y} - rs.x) * rs.y * gg[bj][0] + bb[bj][0];
                        r[bj][1] = ((f32x4){a2.x, a2.y, a3.x, a3.y} - rs.x) * rs.y * gg[bj][1] + bb[bj][1]; }
                } else {
#pragma unroll
                    for (int bj = 0; bj < 2; ++bj)
#pragma unroll
                        for (int n = 0; n < 2; ++n) r[bj][n] = *(const f32x4*)(X + off + bj * HALF + 4 * n);
                }
                float s1 = 0.f, s2 = 0.f;
#pragma unroll
                for (int bj = 0; bj < 2; ++bj) { const f32x4 v0 = r[bj][0] * alpha + acc[ai][bj][m][0] * beta, v1 = r[bj][1] * alpha + acc[ai][bj][m][1] * beta;
                    s1 += (v0[0] + v0[1]) + (v0[2] + v0[3]) + (v1[0] + v1[1]) + (v1[2] + v1[3]);
                    s2 += (v0[0] * v0[0] + v0[1] * v0[1]) + (v0[2] * v0[2] + v0[3] * v0[3]) + (v1[0] * v1[0] + v1[1] * v1[1]) + (v1[2] * v1[2] + v1[3] * v1[3]);
                    u32x4 w; if constexpr (OUT_BF) { w.x = cvt_pk_bf16(v0[0], v0[1]); w.y = cvt_pk_bf16(v0[2], v0[3]); w.z = cvt_pk_bf16(v1[0], v1[1]); w.w = cvt_pk_bf16(v1[2], v1[3]); }
                    else { w.x = cvt_pk_f16(v0[0], v0[1]); w.y = cvt_pk_f16(v0[2], v0[3]); w.z = cvt_pk_f16(v1[0], v1[1]); w.w = cvt_pk_f16(v1[2], v1[3]); }
                    *(u32x4*)(YH + off + bj * HALF) = w;
                    if (YB) { u32x4 wb; wb.x = cvt_pk_bf16(v0[0], v0[1]); wb.y = cvt_pk_bf16(v0[2], v0[3]); wb.z = cvt_pk_bf16(v1[0], v1[1]); wb.w = cvt_pk_bf16(v1[2], v1[3]);
                        *(u32x4*)(YB + off + bj * HALF) = wb; } }
                s1 += __shfl_xor(s1, 16); s1 += __shfl_xor(s1, 32); s2 += __shfl_xor(s2, 16); s2 += __shfl_xor(s2, 32);
                if (fq == 0) P[(ai * HALF + wr * 64 + m * 16 + fr) * 4 + wc] = (f32x2v){s1, s2};
                asm volatile("" ::: "memory"); }
        asm volatile("s_waitcnt lgkmcnt(0)" ::: "memory"); __builtin_amdgcn_s_barrier(); asm volatile("" ::: "memory");
        if (tid < 256) { const f32x2v a = P[tid * 4 + 0], b2 = P[tid * 4 + 1], c = P[tid * 4 + 2], d = P[tid * 4 + 3];
            PS[(size_t)(u.pm * BM + tid) * 4 + u.pn] = (f32x2v){(a.x + b2.x) + (c.x + d.x), (a.y + b2.y) + (c.y + d.y)}; }
    }
};
struct EpiQKV {
    static constexpr bool PERM = true, AFTER_DRAIN = false; static constexpr int NVMEM = 16;
    bf16_t* O; bf16_t* KV; size_t split_stride; float scale0; float* ksum; LnFold lf;
    __device__ __forceinline__ void operator()(const f32x4 (&acc)[2][2][4][2], const Unit& u, int wr_, int wc_, int fr_, int fq_, PG8_LAS unsigned char*, int tid) const {
        int t_ = tid; asm volatile("" : "+v"(t_));
        const int lane_ = t_ & 63, wid_ = __builtin_amdgcn_readfirstlane(t_ >> 6), wr = wid_ >> 2, wc = wid_ & 3, fr = lane_ & 15, fq = lane_ >> 4; (void)wr_; (void)wc_; (void)fr_; (void)fq_;
        const int row0 = u.pm * BM + wr * 64 + fr; const int t = u.pn >> 2; const int colt = (u.pn & 3) * BM;
        bf16_t* base = (t == 0) ? O : KV + (size_t)(t - 1) * split_stride; const float sc = (t == 0) ? scale0 : 1.f;
        const int col0 = colt + wc * 32 + 8 * fq, bcol0 = u.pn * BM + wc * 32 + 8 * fq;
        f32x4 cs[2][2], bw[2][2];
#pragma unroll
        for (int bj = 0; bj < 2; ++bj)
#pragma unroll
            for (int n = 0; n < 2; ++n) { cs[bj][n] = *(const f32x4*)(lf.cs + bcol0 + bj * HALF + 4 * n); bw[bj][n] = *(const f32x4*)(lf.bw + bcol0 + bj * HALF + 4 * n); }
        f32x4 ks[2][2];
#pragma unroll
        for (int bj = 0; bj < 2; ++bj)
#pragma unroll
            for (int n = 0; n < 2; ++n) ks[bj][n] = (f32x4){0.f, 0.f, 0.f, 0.f};
#pragma unroll
        for (int ai = 0; ai < 2; ++ai)
#pragma unroll
            for (int m = 0; m < 4; ++m) { const int row = row0 + ai * HALF + m * 16; bf16_t* rowp = base + (size_t)row * 1024 + col0; const f32x2v rs = lf.RS[((u.pm >> 3) & 3) * BM + (row & (BM - 1))];
#pragma unroll
                for (int bj = 0; bj < 2; ++bj) { const f32x4 v0 = (acc[ai][bj][m][0] - cs[bj][0] * rs.x) * rs.y + bw[bj][0], v1 = (acc[ai][bj][m][1] - cs[bj][1] * rs.x) * rs.y + bw[bj][1];
                    ks[bj][0] += v0; ks[bj][1] += v1;
                    const f32x4 s0 = v0 * sc, s1 = v1 * sc;
                    u32x4 w; w.x = cvt_pk_bf16(s0[0], s0[1]); w.y = cvt_pk_bf16(s0[2], s0[3]); w.z = cvt_pk_bf16(s1[0], s1[1]); w.w = cvt_pk_bf16(s1[2], s1[3]);
                    *(u32x4*)(rowp + bj * HALF) = w; } }
        if (u.pn == 7) {
#pragma unroll
            for (int bj = 0; bj < 2; ++bj)
#pragma unroll
                for (int n = 0; n < 2; ++n)
#pragma unroll
                    for (int e = 0; e < 4; ++e) { float x = ks[bj][n][e]; x += __shfl_xor(x, 1); x += __shfl_xor(x, 2); x += __shfl_xor(x, 4); x += __shfl_xor(x, 8);
                        if (fr == 0) atomicAdd(ksum + (size_t)u.pm * 256 + bj * HALF + wc * 32 + 8 * fq + 4 * n + e, x); }
        }
    }
};
typedef _Float16 f16x8 __attribute__((ext_vector_type(8)));
template <bool F16> __device__ __forceinline__ f32x4 mma_16x16x32(bf16x8 b, bf16x8 a, f32x4 c) {
    if constexpr (F16) return __builtin_amdgcn_mfma_f32_16x16x32_f16(__builtin_bit_cast(f16x8, b), __builtin_bit_cast(f16x8, a), c, 0, 0, 0);
    else return __builtin_amdgcn_mfma_f32_16x16x32_bf16(b, a, c, 0, 0, 0);
}
template <class Epi, class Sched, bool ALIGN_EPI = false, bool SP2 = false, bool F16 = false>
__device__ __forceinline__ void gemm_phase(PG8_LAS unsigned char* lds, const Gemm g, const Sched& S, const Epi& E) {
    const int tid = threadIdx.x, wid = __builtin_amdgcn_readfirstlane(tid >> 6), lane = tid & 63, wr = wid >> 2, wc = wid & 3, fr = lane & 15, fq = lane >> 4;
    const int K = g.K, nt = K / BK;
    constexpr bool PRESTAGE = SP2 && ALIGN_EPI && !Epi::AFTER_DRAIN; constexpr int NV = Epi::NVMEM < 55 ? Epi::NVMEM : 55;
    unsigned voffA[2], voffB[2];
#pragma unroll
    for (int i = 0; i < 2; ++i) { int R, C; stage_rc(tid * 16 + i * 8192, R, C); const int Rb = Epi::PERM ? ((R & ~31) + perm32(R & 31)) : R;
        voffA[i] = (unsigned)(R * K + C) * 2u; voffB[i] = (unsigned)(Rb * K + C) * 2u; }
    const size_t kstep = (size_t)(BK * 2);
    const size_t hstep = (size_t)HALF * K * 2;
    const size_t tstep = 2 * hstep;
    const unsigned ldsw = (unsigned)wid * 1024u;
    const int aoff = lds_byte(wr * 64 + fr, fq * 8), boff = lds_byte(wc * 32 + fr, fq * 8);
#define PG8_SA(b, h) (((b) * 2 + (h)) * HTB)
#define PG8_SB(b, h) ((4 + (b) * 2 + (h)) * HTB)
#define PG8_STAGE(bufoff, gbase, voff) do { _Pragma("unroll") for (int _i = 0; _i < 2; ++_i) \
        __builtin_amdgcn_global_load_lds((const unsigned*)((const char*)(gbase) + (voff)[_i]), (PG8_LAS unsigned*)(lds + (bufoff) + ldsw + _i * 8192), 16, 0, 0); } while (0)
#define PG8_LDA(dst, b, h) do { _Pragma("unroll") for (int m = 0; m < 4; ++m) _Pragma("unroll") for (int k = 0; k < 2; ++k) dst[m][k] = *(const PG8_LAS bf16x8*)(lds + PG8_SA(b, h) + aoff + m * 2048 + k * 1024); } while (0)
#define PG8_LDB(dst, b, h) do { _Pragma("unroll") for (int n = 0; n < 2; ++n) _Pragma("unroll") for (int k = 0; k < 2; ++k) dst[n][k] = *(const PG8_LAS bf16x8*)(lds + PG8_SB(b, h) + boff + n * 2048 + k * 1024); } while (0)
#define PG8_MMA(ai, bj, At, Bt) do { __builtin_amdgcn_s_setprio(1); _Pragma("unroll") for (int m = 0; m < 4; ++m) _Pragma("unroll") for (int n = 0; n < 2; ++n) _Pragma("unroll") for (int k = 0; k < 2; ++k) \
        acc[ai][bj][m][n] = mma_16x16x32<F16>(Bt[n][k], At[m][k], acc[ai][bj][m][n]); __builtin_amdgcn_s_setprio(0); } while (0)
#define PG8_WAIT_V(n) asm volatile("s_waitcnt vmcnt(" #n ")" ::: "memory")
#define PG8_WAIT_VN(n) asm volatile("s_waitcnt vmcnt(%0)" :: "n"(n) : "memory")
#define PG8_WAIT_L(n) asm volatile("s_waitcnt lgkmcnt(" #n ")" ::: "memory")
#define PG8_BAR __builtin_amdgcn_s_barrier()
#define PG8_SCHED __builtin_amdgcn_sched_barrier(0)
    Unit cur, nxt; int ui = 0;
    if (!S.next(0, cur)) return;
    f32x4 acc[2][2][4][2];
#pragma unroll
    for (int a = 0; a < 2; ++a)
#pragma unroll
        for (int b = 0; b < 2; ++b)
#pragma unroll
            for (int m = 0; m < 4; ++m)
#pragma unroll
                for (int n = 0; n < 2; ++n) acc[a][b][m][n] = (f32x4){0.f, 0.f, 0.f, 0.f};
    bf16x8 At[4][2], B0[2][2], B1[2][2];
    const char* cA = (const char*)g.A + (size_t)cur.pm * tstep; const char* cB = (const char*)g.Bt + (size_t)cur.pn * tstep;
    S.a_ready(cur);
    if constexpr (SP2) {
        PG8_STAGE(PG8_SB(0, 0), cB, voffB); PG8_STAGE(PG8_SB(0, 1), cB + hstep, voffB); PG8_STAGE(PG8_SA(0, 0), cA, voffA); PG8_STAGE(PG8_SA(0, 1), cA + hstep, voffA);
        if (wr == 1) PG8_BAR;
        PG8_WAIT_V(2); PG8_BAR;
        PG8_STAGE(PG8_SB(1, 0), cB + kstep, voffB); PG8_STAGE(PG8_SA(1, 0), cA + kstep, voffA); PG8_STAGE(PG8_SB(1, 1), cB + hstep + kstep, voffB);
        if constexpr (PRESTAGE) { PG8_STAGE(PG8_SA(1, 1), cA + hstep + kstep, voffA); PG8_WAIT_V(8); PG8_BAR;
#pragma unroll
            for (int i_ = 0; i_ < NV; ++i_) __builtin_amdgcn_global_load_lds((const unsigned*)((const char*)g.A + tid * 4), (PG8_LAS unsigned*)(lds + STAGE_BYTES + wid * 256), 4, 0, 0);
        } else {
        PG8_WAIT_V(6); PG8_BAR;
        }
    } else {
        PG8_STAGE(PG8_SB(0, 0), cB, voffB); PG8_STAGE(PG8_SA(0, 0), cA, voffA); PG8_STAGE(PG8_SB(0, 1), cB + hstep, voffB); PG8_STAGE(PG8_SA(0, 1), cA + hstep, voffA);
        if (wr == 1) PG8_BAR;
        PG8_WAIT_V(4); PG8_BAR;
        PG8_STAGE(PG8_SB(1, 0), cB + kstep, voffB); PG8_STAGE(PG8_SA(1, 0), cA + kstep, voffA); PG8_STAGE(PG8_SB(1, 1), cB + hstep + kstep, voffB);
        PG8_WAIT_V(6); PG8_BAR;
    }
    for (;;) {
        const bool has_next = S.next(ui + 1, nxt);
        const char* nA = has_next ? (const char*)g.A + (size_t)nxt.pm * tstep : cA; const char* nB = has_next ? (const char*)g.Bt + (size_t)nxt.pn * tstep : cB;
        for (int t = 0; t < nt; t += 2) {
            const bool last = (t == nt - 2);
            const int tsel = PRESTAGE ? t : 1;
            const char* a1 = cA + (size_t)(t + 1) * kstep;
            const char* a2 = last ? nA : cA + (size_t)(t + 2) * kstep; const char* b2 = last ? nB : cB + (size_t)(t + 2) * kstep;
            const char* a3 = a2 + kstep; const char* b3 = b2 + kstep;
            if (last && has_next) S.a_ready(nxt);
#define PG8_WAIT_SEL() asm volatile("s_cmp_eq_u32 %0, 0\n\ts_cbranch_scc1 1f\n\ts_waitcnt vmcnt(8)\n\ts_branch 2f\n1:\n\ts_waitcnt vmcnt(%1)\n2:" :: "s"(tsel), "n"(10 + NV) : "memory", "scc")
            if constexpr (SP2) {
            PG8_LDB(B0, 0, 0); PG8_LDB(B1, 0, 1); PG8_SCHED; PG8_LDA(At, 0, 0); PG8_STAGE(PG8_SA(1, 1), a1 + hstep, voffA);
            PG8_WAIT_SEL(); PG8_WAIT_L(0); PG8_BAR; PG8_MMA(0, 0, At, B0); PG8_MMA(0, 1, At, B1); PG8_BAR; PG8_SCHED;
            PG8_LDA(At, 0, 1); PG8_STAGE(PG8_SB(0, 0), b2, voffB); PG8_STAGE(PG8_SB(0, 1), b2 + hstep, voffB); PG8_STAGE(PG8_SA(0, 0), a2, voffA);
            PG8_WAIT_SEL(); PG8_WAIT_L(0); PG8_BAR; PG8_MMA(1, 0, At, B0); PG8_MMA(1, 1, At, B1); PG8_BAR; PG8_SCHED;
            PG8_LDB(B0, 1, 0); PG8_LDB(B1, 1, 1); PG8_SCHED; PG8_LDA(At, 1, 0); PG8_STAGE(PG8_SA(0, 1), a2 + hstep, voffA);
            PG8_WAIT_SEL(); PG8_WAIT_L(0); PG8_BAR; PG8_MMA(0, 0, At, B0); PG8_MMA(0, 1, At, B1); PG8_BAR; PG8_SCHED;
            PG8_LDA(At, 1, 1); PG8_STAGE(PG8_SB(1, 0), b3, voffB); PG8_STAGE(PG8_SB(1, 1), b3 + hstep, voffB); PG8_STAGE(PG8_SA(1, 0), a3, voffA);
            PG8_WAIT_V(8); PG8_WAIT_L(0); PG8_BAR; PG8_MMA(1, 0, At, B0); PG8_MMA(1, 1, At, B1); PG8_BAR; PG8_SCHED;
            }
#undef PG8_WAIT_SEL
            else {
            PG8_LDB(B0, 0, 0); PG8_SCHED; PG8_LDA(At, 0, 0); PG8_STAGE(PG8_SA(1, 1), a1 + hstep, voffA);
            PG8_WAIT_L(8); PG8_BAR; PG8_WAIT_L(0); PG8_MMA(0, 0, At, B0); PG8_BAR; PG8_SCHED;
            PG8_LDB(B1, 0, 1); PG8_STAGE(PG8_SB(0, 0), b2, voffB);
            PG8_BAR; PG8_WAIT_L(0); PG8_MMA(0, 1, At, B1); PG8_BAR;
            PG8_LDA(At, 0, 1); PG8_STAGE(PG8_SA(0, 0), a2, voffA);
            PG8_BAR; PG8_WAIT_L(0); PG8_MMA(1, 0, At, B0); PG8_BAR; PG8_SCHED;
            PG8_STAGE(PG8_SB(0, 1), b2 + hstep, voffB);
            PG8_WAIT_V(6); PG8_BAR; PG8_MMA(1, 1, At, B1); PG8_BAR;
            PG8_LDB(B0, 1, 0); PG8_SCHED; PG8_LDA(At, 1, 0); PG8_STAGE(PG8_SA(0, 1), a2 + hstep, voffA);
            PG8_WAIT_L(8); PG8_BAR; PG8_WAIT_L(0); PG8_MMA(0, 0, At, B0); PG8_BAR; PG8_SCHED;
            PG8_LDB(B1, 1, 1); PG8_STAGE(PG8_SB(1, 0), b3, voffB);
            PG8_BAR; PG8_WAIT_L(0); PG8_MMA(0, 1, At, B1); PG8_BAR;
            PG8_LDA(At, 1, 1); PG8_STAGE(PG8_SA(1, 0), a3, voffA);
            PG8_BAR; PG8_WAIT_L(0); PG8_MMA(1, 0, At, B0); PG8_BAR; PG8_SCHED;
            PG8_STAGE(PG8_SB(1, 1), b3 + hstep, voffB);
            PG8_WAIT_V(6); PG8_BAR; PG8_MMA(1, 1, At, B1); PG8_BAR;
            }
        }
        if constexpr (ALIGN_EPI) { if (wr == 0) PG8_BAR; }
        if constexpr (PRESTAGE) { if (has_next) PG8_STAGE(PG8_SA(1, 1), nA + kstep + hstep, voffA); }
        if constexpr (!Epi::AFTER_DRAIN) { E(acc, cur, wr, wc, fr, fq, lds + STAGE_BYTES, tid); S.done(cur); }
        if (!has_next) break;
#pragma unroll
        for (int a = 0; a < 2; ++a)
#pragma unroll
            for (int b = 0; b < 2; ++b)
#pragma unroll
                for (int m = 0; m < 4; ++m)
#pragma unroll
                    for (int n = 0; n < 2; ++n) acc[a][b][m][n] = (f32x4){0.f, 0.f, 0.f, 0.f};
        cur = nxt; cA = nA; cB = nB; ++ui;
        if constexpr (ALIGN_EPI) { if (wr == 1) PG8_BAR; }
    }
    PG8_WAIT_V(0);
    if constexpr (!ALIGN_EPI) { if (wr == 0) PG8_BAR; }
    PG8_BAR;
    if constexpr (Epi::AFTER_DRAIN) { E.fused(acc, cur, wr, wc, fr, fq, lds, wid, lane); S.done(cur); }
#undef PG8_SA
#undef PG8_SB
#undef PG8_STAGE
#undef PG8_LDA
#undef PG8_LDB
#undef PG8_MMA
#undef PG8_WAIT_V
#undef PG8_WAIT_VN
#undef PG8_WAIT_L
#undef PG8_BAR
#undef PG8_SCHED
}
}
#ifndef PG8_SP2
#define PG8_SP2 true
#endif
#ifndef PG8_ALIGN
#define PG8_ALIGN true
#endif
constexpr int NWAVES = 8;
constexpr int BATCH = 32, SEQ = 2048, D = 1024, FF = 2816, NGU = 2 * FF, NQKV = 3 * D, HD = 64;
constexpr int M = BATCH * SEQ;
constexpr int NHA = 12, NHB = 4, WIDTH_A = NHA * HD, WIDTH_B = NHB * HD;
constexpr float LN_EPS = 1e-5f;
constexpr float ALPHA = 1.189207115002721f;
constexpr float QSCALE = 0.125f * 1.4426950408889634f;
constexpr size_t MiB = 1u << 20;
constexpr size_t WS_CTL = 0, WS_KS = 1 * MiB, CTL_ZERO_BYTES = 2 * MiB;
constexpr size_t WS_W1T = 2 * MiB, WS_W2T = 13 * MiB, WS_WINT = 19 * MiB, WS_WOT = 25 * MiB, WS_W3T = 27 * MiB, WS_W4T = 38 * MiB;
constexpr size_t WS_VEC = 44 * MiB;
constexpr size_t WS_PS = 45 * MiB;
constexpr size_t WS_RS = 51 * MiB;
constexpr size_t WS_AB = 64 * MiB;
constexpr size_t WS_YH = 192 * MiB;
constexpr size_t WS_R1 = 320 * MiB;
constexpr size_t WS_OB = 704 * MiB;
constexpr size_t WS_END = 832 * MiB;
static_assert(WS_W1T + (size_t)NGU * D * 2 <= WS_W2T && WS_W2T + (size_t)D * FF * 2 <= WS_WINT && WS_WINT + (size_t)NQKV * D * 2 <= WS_WOT && WS_WOT + (size_t)D * D * 2 <= WS_W3T &&
              WS_W3T + (size_t)NGU * D * 2 <= WS_W4T && WS_W4T + (size_t)D * FF * 2 <= WS_VEC && WS_VEC + (size_t)(2 * NQKV + 2 * NGU) * 4 <= WS_PS && WS_PS + (size_t)3 * M * 32 <= WS_RS &&
              WS_RS + (size_t)2 * M * 8 <= WS_AB && WS_AB + (size_t)M * D * 2 <= WS_YH && WS_YH + (size_t)M * D * 2 <= WS_R1 &&
              WS_R1 + (size_t)3 * M * D * 2 <= WS_OB && WS_R1 + (size_t)M * FF * 2 <= WS_OB && WS_OB + (size_t)M * D * 2 <= WS_END, "d_ws map");
constexpr int CW_BAR = 4096;
constexpr int CW_LBAR = 8192;
constexpr int CW_BAD = 12288;
constexpr int CW_ADONE = 24576;
constexpr int CW_PANEL = 32768;
constexpr int CW_QUEUE = 16384;
constexpr int RING_OFF = 0, RING_BYTES = 131072;
constexpr int LDSCTL_OFF = RING_BYTES + 8192, MISC_OFF = LDSCTL_OFF + 320;
constexpr int RSL_OFF = 147456;
constexpr int LDS_BYTES = 155648;
static_assert(MISC_OFF + 128 <= RSL_OFF && RSL_OFF + 8192 <= LDS_BYTES, "LDS map");
#define GAS __attribute__((address_space(1)))
#define LAS __attribute__((address_space(3)))
typedef unsigned short bf16;
typedef unsigned v4u __attribute__((ext_vector_type(4)));
typedef float f32x4 __attribute__((ext_vector_type(4)));
typedef short bf16x8 __attribute__((ext_vector_type(8)));
typedef GAS unsigned gu32;
typedef GAS unsigned long long gu64;
#define RLX_AGENT __ATOMIC_RELAXED, __HIP_MEMORY_SCOPE_AGENT
#define LDS_WAIT() asm volatile("s_waitcnt lgkmcnt(0)" ::: "memory")
#define VM_WAIT() asm volatile("s_waitcnt vmcnt(0)" ::: "memory")
__device__ __forceinline__ unsigned long long rt() { return __builtin_amdgcn_s_memrealtime(); }
__device__ __forceinline__ unsigned f2bf(float f) { unsigned u = __builtin_bit_cast(unsigned, f); return (u + 0x7fffu + ((u >> 16) & 1u)) >> 16; }
__device__ __forceinline__ unsigned pk2(float lo, float hi) { return f2bf(lo) | (f2bf(hi) << 16); }
#define XB_TMO      128
#define XB_XCNT(j)  (256  + 64 * (j))
#define XB_XSUB(j)  (1280 + 64 * (j))
#define XB_XGEN(j)  (2304 + 64 * (j))
#define XB_TOP      3328
#define XB_TOPGEN   3392
#define XCD_BAR_WORDS 3456
#define XB_SPIN_CAP (1u << 18)

__device__ __forceinline__ unsigned xb_ld(unsigned* p)              { return __hip_atomic_load(p, __ATOMIC_RELAXED, __HIP_MEMORY_SCOPE_AGENT); }
__device__ __forceinline__ unsigned xb_add(unsigned* p, unsigned v) { return __hip_atomic_fetch_add(p, v, __ATOMIC_RELAXED, __HIP_MEMORY_SCOPE_AGENT); }
__device__ __forceinline__ unsigned xb_xcc_id() { return (unsigned)__builtin_amdgcn_s_getreg((3 << 11) | 20) & 0xFu; }
#define XB_SPIN(cond, bar) do { unsigned _sp = 0; while (cond) { __builtin_amdgcn_s_sleep(1); \
    if ((++_sp & 255u) == 0u) { if (xb_ld(&(bar)[XB_TMO])) break; if (_sp > XB_SPIN_CAP) { atomicAdd(&(bar)[XB_TMO], 1u); break; } } } } while (0)

struct XcdBarrier {
    unsigned* bar; unsigned x;
    volatile LAS unsigned* st;
};

__device__ __forceinline__ XcdBarrier xcd_barrier_post(unsigned* bar, volatile LAS unsigned* st) {
    XcdBarrier b; b.bar = bar; b.x = xb_xcc_id(); b.st = st;
    if (threadIdx.x == 0) (void)xb_add(&bar[XB_XCNT(b.x)], 1u);
    return b;
}
__device__ __forceinline__ void xcd_barrier_complete(unsigned* bar, unsigned x, unsigned& nloc, unsigned& nx) {
    const unsigned G = gridDim.x * gridDim.y * gridDim.z;
    unsigned sum, cnt, mine, sp = 0u;
    for (;;) {
        sum = 0u; cnt = 0u; mine = 0u;
#pragma unroll
        for (unsigned j = 0; j < 16; ++j) { const unsigned c = xb_ld(&bar[XB_XCNT(j)]); sum += c; cnt += (c > 0u) ? 1u : 0u; mine = (j == x) ? c : mine; }
        if (sum == G) break;
        __builtin_amdgcn_s_sleep(1);
        if ((++sp & 255u) == 0u) { if (xb_ld(&bar[XB_TMO])) break; if (sp > XB_SPIN_CAP) { atomicAdd(&bar[XB_TMO], 1u); break; } }
    }
    nloc = mine > 0u ? mine : 1u; nx = cnt > 0u ? cnt : 1u;
}

__device__ __forceinline__ void xcd_barrier(const XcdBarrier& b) {
    asm volatile("s_waitcnt vmcnt(0)" ::: "memory");
    __syncthreads();
    if (threadIdx.x == 0) {
        unsigned* bar = b.bar;
        __builtin_amdgcn_s_waitcnt(0);
        unsigned nloc = b.st[0], nx = b.st[1];
        if (nloc == 0u) { xcd_barrier_complete(bar, b.x, nloc, nx); b.st[0] = nloc; b.st[1] = nx; }
        const unsigned old = xb_add(&bar[XB_XSUB(b.x)], 1u);
        const unsigned gen = old / nloc;
        if (old + 1u == (gen + 1u) * nloc) {
            __builtin_amdgcn_fence(__ATOMIC_RELEASE, "agent");
            asm volatile("s_waitcnt vmcnt(0)" ::: "memory");
            const unsigned og = xb_add(&bar[XB_TOP], 1u);
            const unsigned tg = og / nx;
            if (og + 1u == (tg + 1u) * nx) xb_add(&bar[XB_TOPGEN], 1u);
            else XB_SPIN(xb_ld(&bar[XB_TOPGEN]) == tg, bar);
            __builtin_amdgcn_fence(__ATOMIC_ACQUIRE, "agent");
            xb_add(&bar[XB_XGEN(b.x)], 1u);
            asm volatile("s_waitcnt vmcnt(0)" ::: "memory");
        } else {
            XB_SPIN(xb_ld(&bar[XB_XGEN(b.x)]) == gen, bar);
            __builtin_amdgcn_fence(__ATOMIC_ACQUIRE, "agent");
            asm volatile("s_waitcnt vmcnt(0)" ::: "memory");
        }
    }
    __syncthreads();
}
__device__ __forceinline__ void seam(const XcdBarrier& b, int local, gu32* lcnt, unsigned target) {
    if (local) {
        asm volatile("s_waitcnt vmcnt(0)" ::: "memory");
        __syncthreads();
        if (threadIdx.x == 0) {
            __builtin_amdgcn_s_waitcnt(0);
            (void)xb_add((unsigned*)lcnt, 1u);
            XB_SPIN(xb_ld((unsigned*)lcnt) < target, b.bar);
            __builtin_amdgcn_fence(__ATOMIC_ACQUIRE, "agent");
            asm volatile("s_waitcnt vmcnt(0)" ::: "memory");
        }
        __syncthreads();
    } else xcd_barrier(b);
}
struct Frame {
    LAS unsigned char* lds;
    volatile LAS unsigned* MISC;
    gu32* ctl;
    int tid, lane, wave;
    int local;
    int vcu, G;
    const float* x; float* out;
    const float *g1w, *u1w, *d1w, *ln1g, *ln1b, *win, *wout, *ln2g, *ln2b, *g2w, *u2w, *d2w, *ln3g, *ln3b;
    bf16 *W1T, *W2T, *WINT, *WOT, *W3T, *W4T;
    bf16 *AB, *HB, *QB, *KB, *VB, *OB;
    unsigned short* YH;
    pg8::f32x2v *PS1, *PS2, *PS3, *RS1, *RS2;
    float *KS, *CSIN, *BWIN, *CS3, *BW3;
};

__device__ __forceinline__ float wave_sum(float v) {
#pragma unroll
    for (int o = 1; o < 64; o <<= 1) v += __shfl_xor(v, o);
    return v;
}
__device__ __forceinline__ int dest_row(int kind, int n0) {
    if (kind == 0) return n0;
    if (kind == 1) return 256 * (n0 >> 7) + (n0 & 127);
    if (kind == 2) return 256 * (n0 >> 7) + 128 + (n0 & 127);
    if (n0 < WIDTH_A) return n0;
    if (n0 < 2 * WIDTH_A) return D + (n0 - WIDTH_A);
    if (n0 < 3 * WIDTH_A) return 2 * D + (n0 - 2 * WIDTH_A);
    if (n0 < 3 * WIDTH_A + WIDTH_B) return WIDTH_A + (n0 - 3 * WIDTH_A);
    if (n0 < 3 * WIDTH_A + 2 * WIDTH_B) return D + WIDTH_A + (n0 - 3 * WIDTH_A - WIDTH_B);
    return 2 * D + WIDTH_A + (n0 - 3 * WIDTH_A - 2 * WIDTH_B);
}
__device__ __forceinline__ void p0_transpose_item(const float* W, int K, int N, bf16* WT, int kind, const float* gain, LAS float* scr, int item, int lane) {
    const int nblk = N / 32, kb = item / nblk, nb = item % nblk, k0 = 64 * kb, n0 = 32 * nb;
    const int drow0 = dest_row(kind, n0);
#pragma unroll 8
    for (int i = 0; i < 32; ++i) { const int kk = 2 * i + (lane >> 5); float wv = W[(size_t)(k0 + kk) * N + n0 + (lane & 31)]; if (gain) wv *= gain[k0 + kk]; scr[kk * 33 + (lane & 31)] = wv; }
    LDS_WAIT(); asm volatile("" ::: "memory");
    const int c = lane & 7;
#pragma unroll
    for (int j = 0; j < 4; ++j) { const int n = (lane >> 3) + 8 * j; const LAS float* s = scr + (8 * c) * 33 + n;
        v4u o; o.x = pk2(s[0 * 33], s[1 * 33]); o.y = pk2(s[2 * 33], s[3 * 33]); o.z = pk2(s[4 * 33], s[5 * 33]); o.w = pk2(s[6 * 33], s[7 * 33]);
        *(GAS v4u*)(WT + (size_t)(drow0 + n) * K + k0 + 8 * c) = o; }
    LDS_WAIT(); asm volatile("" ::: "memory");
}
__device__ __forceinline__ void cvt_row_to_bf16(int lane, const float* xrow, bf16* orow) {
    const GAS f32x4* xr = (const GAS f32x4*)xrow + lane;
    f32x4 v[4];
#pragma unroll
    for (int j = 0; j < 4; ++j) v[j] = xr[64 * j];
    GAS unsigned long long* o8 = (GAS unsigned long long*)orow + lane;
#pragma unroll
    for (int j = 0; j < 4; ++j) o8[64 * j] = (unsigned long long)pk2(v[j].x, v[j].y) | ((unsigned long long)pk2(v[j].z, v[j].w) << 32);
}
__device__ __forceinline__ void fold_task(Frame& F, const float* W, int N, int kind, const float* g, const float* b, float* cs, float* bw, int task) {
    const int n = 64 * task + F.lane; float a = 0.f, c = 0.f;
#pragma unroll 8
    for (int k = 128 * F.wave; k < 128 * F.wave + 128; ++k) { const float w = W[(size_t)k * N + n]; const unsigned hb = pk2(w * g[k], 0.f) & 0xffffu; a += __uint_as_float(hb << 16); c += w * b[k]; }
    LAS float* T = (LAS float*)(F.lds + RING_OFF);
    T[(F.wave * 64 + F.lane) * 2] = a; T[(F.wave * 64 + F.lane) * 2 + 1] = c;
    __syncthreads();
    if (F.tid < 64) { float sa = 0.f, sc = 0.f;
#pragma unroll
        for (int w = 0; w < 8; ++w) { sa += T[(w * 64 + F.tid) * 2]; sc += T[(w * 64 + F.tid) * 2 + 1]; }
        const int nd = dest_row(kind, n & ~31) + (n & 31); cs[nd] = sa; bw[nd] = sc; }
    __syncthreads();
}
__device__ __forceinline__ void p0_prologue(Frame& F) {
    LAS float* scr = (LAS float*)(F.lds + RING_OFF + F.wave * 16384);
    const int gw = F.vcu * NWAVES + F.wave, NGW = F.G * NWAVES;
    for (int t = F.vcu; t < NQKV / 64 + 2 * (FF / 64); t += F.G) {
        if (t < NQKV / 64) fold_task(F, F.win, NQKV, 3, F.ln1g, F.ln1b, F.CSIN, F.BWIN, t);
        else if (t < NQKV / 64 + FF / 64) fold_task(F, F.g2w, FF, 1, F.ln2g, F.ln2b, F.CS3, F.BW3, t - NQKV / 64);
        else fold_task(F, F.u2w, FF, 2, F.ln2g, F.ln2b, F.CS3, F.BW3, t - NQKV / 64 - FF / 64);
    }
    constexpr int I_GU = (D / 64) * (FF / 32), I_DN = (FF / 64) * (D / 32), I_IN = (D / 64) * (NQKV / 32), I_OUT = (D / 64) * (D / 32);
    constexpr int NITEMS = 4 * I_GU + 2 * I_DN + I_IN + I_OUT;
    for (int it = gw; it < NITEMS; it += NGW) {
        int r = it;
        if (r < I_GU) { p0_transpose_item(F.g1w, D, FF, F.W1T, 1, nullptr, scr, r, F.lane); continue; } r -= I_GU;
        if (r < I_GU) { p0_transpose_item(F.u1w, D, FF, F.W1T, 2, nullptr, scr, r, F.lane); continue; } r -= I_GU;
        if (r < I_DN) { p0_transpose_item(F.d1w, FF, D, F.W2T, 0, nullptr, scr, r, F.lane); continue; } r -= I_DN;
        if (r < I_IN) { p0_transpose_item(F.win, D, NQKV, F.WINT, 3, F.ln1g, scr, r, F.lane); continue; } r -= I_IN;
        if (r < I_OUT) { p0_transpose_item(F.wout, D, D, F.WOT, 0, nullptr, scr, r, F.lane); continue; } r -= I_OUT;
        if (r < I_GU) { p0_transpose_item(F.g2w, D, FF, F.W3T, 1, F.ln2g, scr, r, F.lane); continue; } r -= I_GU;
        if (r < I_GU) { p0_transpose_item(F.u2w, D, FF, F.W3T, 2, F.ln2g, scr, r, F.lane); continue; } r -= I_GU;
        p0_transpose_item(F.d2w, FF, D, F.W4T, 0, nullptr, scr, r, F.lane);
    }
    for (int m = gw; m < M; m += NGW) cvt_row_to_bf16(F.lane, F.x + (size_t)m * D, F.AB + (size_t)m * D);
}
__device__ __forceinline__ void fill_row_stats(Frame& F, const pg8::f32x2v* PS, int pm0) {
    LAS pg8::f32x2v* T = (LAS pg8::f32x2v*)(F.lds + RSL_OFF);
    const int k = F.tid >> 7, rl = (F.tid & 127) * 2, pm = (pm0 & ~31) + 8 * k + (pm0 & 7);
#pragma unroll
    for (int e = 0; e < 2; ++e) { const size_t row = (size_t)pm * 256 + rl + e;
        const f32x4 a = *(const GAS f32x4*)(PS + row * 4), b = *(const GAS f32x4*)(PS + row * 4 + 2);
        const float s1 = (a.x + a.z) + (b.x + b.z), s2 = (a.y + a.w) + (b.y + b.w);
        const float mean = s1 * (1.f / D), var = fmaxf(s2 * (1.f / D) - mean * mean, 0.f);
        T[k * 256 + rl + e] = (pg8::f32x2v){mean, 1.f / sqrtf(var + LN_EPS)}; }
    __syncthreads();
}
__device__ __forceinline__ void final_phase(Frame& F) {
    const int gw = F.local ? (int)(blockIdx.x >> 3) * NWAVES + F.wave : F.vcu * NWAVES + F.wave, NGW = F.local ? 32 * NWAVES : F.G * NWAVES;
    const int mbeg = F.local ? (int)(blockIdx.x & 7u) * (M / 8) : 0, mend = F.local ? mbeg + M / 8 : M;
    f32x4 gg[2][2], bb[2][2];
#pragma unroll
    for (int j = 0; j < 2; ++j)
#pragma unroll
        for (int n = 0; n < 2; ++n) { gg[j][n] = *(const GAS f32x4*)(F.ln3g + 512 * j + 8 * F.lane + 4 * n); bb[j][n] = *(const GAS f32x4*)(F.ln3b + 512 * j + 8 * F.lane + 4 * n); }
    for (int m = mbeg + gw; m < mend; m += NGW) {
        const f32x4 a = *(const GAS f32x4*)(F.PS3 + (size_t)m * 4), b = *(const GAS f32x4*)(F.PS3 + (size_t)m * 4 + 2);
        const float s1 = (a.x + a.z) + (b.x + b.z), s2 = (a.y + a.w) + (b.y + b.w);
        const float mean = s1 * (1.f / D), var = fmaxf(s2 * (1.f / D) - mean * mean, 0.f), rstd = 1.f / sqrtf(var + LN_EPS);
#pragma unroll
        for (int j = 0; j < 2; ++j) { const v4u hw = *(const GAS v4u*)(F.YH + (size_t)m * D + 512 * j + 8 * F.lane);
            const pg8::f32x2v a0 = pg8::unpk_f16(hw.x), a1 = pg8::unpk_f16(hw.y), a2 = pg8::unpk_f16(hw.z), a3 = pg8::unpk_f16(hw.w);
            const f32x4 o0 = ((f32x4){a0.x, a0.y, a1.x, a1.y} - mean) * rstd * gg[j][0] + bb[j][0], o1 = ((f32x4){a2.x, a2.y, a3.x, a3.y} - mean) * rstd * gg[j][1] + bb[j][1];
            GAS f32x4* op = (GAS f32x4*)(F.out + (size_t)m * D + 512 * j + 8 * F.lane); op[0] = o0; op[1] = o1; }
    }
}
namespace att {
typedef float f32x16 __attribute__((ext_vector_type(16)));
typedef short bf16x8 __attribute__((ext_vector_type(8)));
typedef short s16x4 __attribute__((ext_vector_type(4)));
typedef short v4i16_t __attribute__((ext_vector_type(4)));
typedef float f32x2_t __attribute__((ext_vector_type(2)));
typedef __bf16 bf16x2_t __attribute__((ext_vector_type(2)));
constexpr int ST_O = 65536, ST_M = 131072, ST_L = 131072 + 2048;
constexpr float THR = 6.0f;
constexpr float LOG2E = 1.4426950408889634f;
constexpr int UNITS_PER_BATCH = NHB * 8 + NHA * 4, UNITS_PER_XCD = (BATCH / 8) * UNITS_PER_BATCH;
__device__ __forceinline__ unsigned cvt2(float lo, float hi) { f32x2_t v = {lo, hi}; bf16x2_t b = __builtin_convertvector(v, bf16x2_t); return __builtin_bit_cast(unsigned, b); }
__device__ __forceinline__ s16x4 vtr(LAS const char* p) { return __builtin_bit_cast(s16x4, __builtin_amdgcn_ds_read_tr16_b64_v4i16((LAS v4i16_t*)p)); }
__device__ __forceinline__ float max_raw(float a, float b) { float r; asm("v_max_f32 %0, %1, %2" : "=v"(r) : "v"(a), "v"(b)); return r; }
#define ATT_RM_BODY "v_max3_f32 %0, %3, %4, %5\n\tv_max3_f32 %1, %6, %7, %8\n\tv_max3_f32 %2, %9, %10, %11\n\tv_max3_f32 %0, %0, %1, %2\n\tv_max3_f32 %1, %12, %13, %14\n\tv_max3_f32 %2, %15, %16, %17\n\tv_max3_f32 %1, %1, %2, %18\n\tv_max_f32 %0, %0, %1"
#define ATT_RM_OPS(s) "v"(s[0]), "v"(s[1]), "v"(s[2]), "v"(s[3]), "v"(s[4]), "v"(s[5]), "v"(s[6]), "v"(s[7]), "v"(s[8]), "v"(s[9]), "v"(s[10]), "v"(s[11]), "v"(s[12]), "v"(s[13]), "v"(s[14]), "v"(s[15])
template <int PAD> __device__ __forceinline__ float rowmax16(const f32x16& s) {
    float t0, t1, t2;
    if (PAD == 2) asm("s_nop 15\n\ts_nop 7\n\t" ATT_RM_BODY : "=&v"(t0), "=&v"(t1), "=&v"(t2) : ATT_RM_OPS(s));
    else if (PAD == 1) asm("s_nop 7\n\t" ATT_RM_BODY : "=&v"(t0), "=&v"(t1), "=&v"(t2) : ATT_RM_OPS(s));
    else asm(ATT_RM_BODY : "=&v"(t0), "=&v"(t1), "=&v"(t2) : ATT_RM_OPS(s));
    return t0;
}
__device__ __forceinline__ float rowmax16_after(const f32x16& s, float dep) {
    float t0, t1, t2;
    asm(ATT_RM_BODY : "=&v"(t0), "=&v"(t1), "=&v"(t2) : ATT_RM_OPS(s), "v"(dep));
    return t0;
}
__device__ __forceinline__ float swap_max(float v) { auto rr = __builtin_amdgcn_permlane32_swap(__float_as_uint(v), __float_as_uint(v), false, false); return max_raw(__uint_as_float(rr[0]), __uint_as_float(rr[1])); }
__device__ __forceinline__ float swap_add(float v) { auto rr = __builtin_amdgcn_permlane32_swap(__float_as_uint(v), __float_as_uint(v), false, false); return __uint_as_float(rr[0]) + __uint_as_float(rr[1]); }
#define ATT_CROW(r) (((r) & 3) + 8 * ((r) >> 2))
__device__ __forceinline__ void touch_line(const void* gptr, unsigned lds_dst  ) {
    unsigned keep;
    asm volatile("s_mov_b32 %0, m0\n\ts_mov_b32 m0, %2\n\ts_nop 0\n\tglobal_load_lds_dword %1, off\n\ts_mov_b32 m0, %0" : "=&s"(keep) : "v"(gptr), "s"(lds_dst) : "memory");
}
constexpr int ST_DUMMY = ST_L + 1024;

struct LaneC {
    LAS char *kw_e, *kw_o, *vw;
    LAS const char *ka[4];
    LAS const char *va[2];
};
struct Run {
    unsigned off;
    unsigned tstep, rstride;
    int nt;
    float wl0, wstep;
    int thr_c, thr_w; bool causal_first, window_last;
    unsigned noff, nrstride, nqoff;
};

#define ATT_SB() __builtin_amdgcn_sched_barrier(0)
template <bool TWO> __device__ __forceinline__ void softmax_tiles(f32x16& sA, f32x16& sB, float wlA, float wlB, f32x16& o0, f32x16& o1, float& m, float& l) {
    float mt;
    if (TWO) { const float ra = rowmax16<2>(sA); const float rb = rowmax16_after(sB, ra); mt = max_raw(ra + wlA, rb + wlB); }
    else mt = rowmax16<1>(sA) + wlA;
    mt = swap_max(mt);
    if (__any(mt > m + THR)) {
        const float mn = fmaxf(m, mt), f = __builtin_amdgcn_exp2f(m - mn);
        o0 *= f; o1 *= f; l *= f; m = mn;
    }
    const float subA = m - wlA, subB = m - wlB;
    float ls = 0.f;
#pragma unroll
    for (int r = 0; r < 16; ++r) { sA[r] = __builtin_amdgcn_exp2f(sA[r] - subA); ls += sA[r]; }
    if (TWO) {
#pragma unroll
        for (int r = 0; r < 16; ++r) { sB[r] = __builtin_amdgcn_exp2f(sB[r] - subB); ls += sB[r]; }
    }
    l += ls;
    asm volatile("" : "+v"(l));
}
__device__ __forceinline__ void pack_p(const f32x16& s, bf16x8& pb0, bf16x8& pb1) {
    v4u pw0, pw1;
    pw0.x = cvt2(s[0], s[1]); pw0.y = cvt2(s[2], s[3]); pw0.z = cvt2(s[4], s[5]); pw0.w = cvt2(s[6], s[7]);
    pw1.x = cvt2(s[8], s[9]); pw1.y = cvt2(s[10], s[11]); pw1.z = cvt2(s[12], s[13]); pw1.w = cvt2(s[14], s[15]);
    pb0 = __builtin_bit_cast(bf16x8, pw0); pb1 = __builtin_bit_cast(bf16x8, pw1);
}
#define ATT_VF(lo, hi) ((bf16x8){lo[0], lo[1], lo[2], lo[3], hi[0], hi[1], hi[2], hi[3]})

__device__ __forceinline__ void load_q_off(bf16x8 (&qf)[4], const char* qbase  , unsigned off  ) {
#pragma unroll
    for (int ks = 0; ks < 4; ++ks) qf[ks] = *(const GAS bf16x8*)(qbase + 32 * ks + off);
}
__device__ __forceinline__ void run_tiles(const LaneC& C, const Run& R, const char* kbase, const char* vbase, const char* qbase, const bf16x8 (&qf)[4], bf16x8 (&qn)[4], v4u (&kst)[4], v4u (&vst)[4],
                                          const f32x16& Kc, f32x16& o0, f32x16& o1, float& m, float& l) {
    unsigned off = R.off;
#define ATT_ISSUE_K() do { _Pragma("unroll") for (int i_ = 0; i_ < 4; ++i_) kst[i_] = *(const GAS v4u*)(kbase + (size_t)(i_ * R.rstride) + off); } while (0)
#define ATT_ISSUE_V() do { _Pragma("unroll") for (int i_ = 0; i_ < 4; ++i_) vst[i_] = *(const GAS v4u*)(vbase + (size_t)(i_ * R.rstride) + off); off += R.tstep; } while (0)
#define ATT_PREF_KQ() do { _Pragma("unroll") for (int i_ = 0; i_ < 4; ++i_) kst[i_] = *(const GAS v4u*)(kbase + (size_t)(i_ * R.nrstride) + R.noff); load_q_off(qn, qbase, R.nqoff); } while (0)
#define ATT_PREF_V() do { _Pragma("unroll") for (int i_ = 0; i_ < 4; ++i_) vst[i_] = *(const GAS v4u*)(vbase + (size_t)(i_ * R.nrstride) + R.noff); } while (0)
#define ATT_COMMIT_K() do { *(LAS v4u*)(C.kw_e) = kst[0]; *(LAS v4u*)(C.kw_o) = kst[1]; *(LAS v4u*)(C.kw_e + 2048) = kst[2]; *(LAS v4u*)(C.kw_o + 2048) = kst[3]; } while (0)
#define ATT_COMMIT_V() do { _Pragma("unroll") for (int i_ = 0; i_ < 4; ++i_) *(LAS v4u*)(C.vw + 1024 * i_) = vst[i_]; } while (0)
    ATT_COMMIT_K(); ATT_COMMIT_V();
    if (R.nt > 1) { ATT_ISSUE_K(); ATT_ISSUE_V(); } else { ATT_PREF_KQ(); ATT_PREF_V(); }
    bf16x8 kf[4];
#pragma unroll
    for (int ks = 0; ks < 4; ++ks) kf[ks] = *(const LAS bf16x8*)C.ka[ks];
    ATT_SB();
    float wl = R.wl0;
    f32x16 s = Kc, sdummy;
#pragma unroll
    for (int ks = 0; ks < 4; ++ks) s = __builtin_amdgcn_mfma_f32_32x32x16_bf16(kf[ks], qf[ks], s, 0, 0, 0);
#define ATT_STEP(MORE, ISS, PREF) do { \
        const s16x4 a0 = vtr(C.va[0]), a1 = vtr(C.va[0] + 1024), a2 = vtr(C.va[0] + 2048), a3 = vtr(C.va[0] + 3072); \
        const s16x4 b0 = vtr(C.va[1]), b1 = vtr(C.va[1] + 1024), b2 = vtr(C.va[1] + 2048), b3 = vtr(C.va[1] + 3072); \
        ATT_SB(); \
        if (t == 0 && R.causal_first) { \
_Pragma("unroll") \
            for (int r = 0; r < 16; ++r) s[r] = (ATT_CROW(r) <= R.thr_c) ? s[r] : -INFINITY; \
        } \
        if (!(MORE) && R.window_last) { \
_Pragma("unroll") \
            for (int r = 0; r < 16; ++r) s[r] = (ATT_CROW(r) >= R.thr_w) ? s[r] : -INFINITY; \
        } \
        softmax_tiles<false>(s, sdummy, wl, 0.f, o0, o1, m, l); \
        bf16x8 pb0, pb1; pack_p(s, pb0, pb1); \
        o0 = __builtin_amdgcn_mfma_f32_32x32x16_bf16(ATT_VF(a0, a1), pb0, o0, 0, 0, 0); o1 = __builtin_amdgcn_mfma_f32_32x32x16_bf16(ATT_VF(b0, b1), pb0, o1, 0, 0, 0); \
        o0 = __builtin_amdgcn_mfma_f32_32x32x16_bf16(ATT_VF(a2, a3), pb1, o0, 0, 0, 0); o1 = __builtin_amdgcn_mfma_f32_32x32x16_bf16(ATT_VF(b2, b3), pb1, o1, 0, 0, 0); \
        ATT_SB(); \
        wl -= R.wstep; \
        if (MORE) { \
            ATT_COMMIT_K(); if (ISS) ATT_ISSUE_K(); if (PREF) ATT_PREF_KQ(); \
            ATT_COMMIT_V(); \
            if (ISS) ATT_ISSUE_V(); \
            if (PREF) ATT_PREF_V(); \
_Pragma("unroll") \
            for (int ks = 0; ks < 4; ++ks) kf[ks] = *(const LAS bf16x8*)C.ka[ks]; \
            ATT_SB(); \
            s = Kc; \
_Pragma("unroll") \
            for (int ks = 0; ks < 4; ++ks) s = __builtin_amdgcn_mfma_f32_32x32x16_bf16(kf[ks], qf[ks], s, 0, 0, 0); \
        } \
        ATT_SB(); } while (0)
    int t = 0;
#pragma nounroll
    for (; t + 2 < R.nt; ++t) ATT_STEP(1, 1, 0);
    if (t + 1 < R.nt) { ATT_STEP(1, 0, 1); ++t; }
    ATT_STEP(0, 0, 0);
#undef ATT_STEP
#undef ATT_ISSUE_K
#undef ATT_ISSUE_V
#undef ATT_PREF_KQ
#undef ATT_PREF_V
#undef ATT_COMMIT_K
#undef ATT_COMMIT_V
}

struct ShC { LAS char* kw; LAS char* vw; LAS const char* ka[4]; LAS const char* va[2]; };
__device__ __forceinline__ LAS float* st_o(LAS char* lds, int tau, int chunk) { return (LAS float*)(lds + ST_O + tau * 256 + (((chunk ^ tau ^ (tau >> 4)) & 15) << 4)); }
template <bool MERGE> __device__ __forceinline__ void state_put(LAS char* lds, int tau, int hi, const f32x16& o0, const f32x16& o1, float m, float l) {
    const float lt = swap_add(l);
    float fo = 1.f, fx = 0.f, lx = 0.f;
    LAS float* pm = (LAS float*)(lds + ST_M) + tau; LAS float* pl = (LAS float*)(lds + ST_L) + tau;
    if (MERGE) { const float mx = *pm; lx = *pl; const float mn = fmaxf(m, mx); fo = __builtin_amdgcn_exp2f(m - mn); fx = __builtin_amdgcn_exp2f(mx - mn); m = mn; }
#pragma unroll
    for (int d0 = 0; d0 < 2; ++d0)
#pragma unroll
        for (int g = 0; g < 4; ++g) { LAS f32x4* p = (LAS f32x4*)st_o(lds, tau, 8 * d0 + 2 * g + hi);
            f32x4 v = d0 == 0 ? (f32x4){o0[4 * g], o0[4 * g + 1], o0[4 * g + 2], o0[4 * g + 3]} : (f32x4){o1[4 * g], o1[4 * g + 1], o1[4 * g + 2], o1[4 * g + 3]};
            if (MERGE) { const f32x4 x = *p; v = v * fo + x * fx; }
            *p = v; }
    if (hi == 0) { *pm = m; *pl = lt * fo + lx * fx; }
}
__device__ __forceinline__ void state_store(LAS char* lds, int w, int lane, bf16* orow0  ) {
#pragma unroll
    for (int i = 0; i < 4; ++i) { const int tau = 32 * w + 8 * i + (lane >> 3), pc = lane & 7;
        const f32x4 a = *(LAS f32x4*)st_o(lds, tau, 2 * pc), b = *(LAS f32x4*)st_o(lds, tau, 2 * pc + 1);
        const float rl = 1.0f / *((LAS float*)(lds + ST_L) + tau);
        v4u o; o.x = cvt2(a[0] * rl, a[1] * rl); o.y = cvt2(a[2] * rl, a[3] * rl); o.z = cvt2(b[0] * rl, b[1] * rl); o.w = cvt2(b[2] * rl, b[3] * rl);
        *(GAS v4u*)(orow0 + (size_t)tau * D + 8 * pc) = o; }
}
__device__ __forceinline__ void load_q(bf16x8 (&qf)[4], const bf16* qrow  , int hi) {
#pragma unroll
    for (int ks = 0; ks < 4; ++ks) qf[ks] = *(const GAS bf16x8*)(qrow + 16 * ks + 8 * hi);
}

typedef _Float16 h16x4 __attribute__((ext_vector_type(4)));
__device__ __forceinline__ LAS h16x4* dst_slot(LAS char* lds, int tau, int slot) { return (LAS h16x4*)(lds + ST_O + tau * 128 + (((slot ^ tau ^ (tau >> 4)) & 15) << 3)); }
template <bool MERGE> __device__ __forceinline__ void dstate_put(LAS char* lds, int tau, int hi, const f32x16& o0, const f32x16& o1, float m, float l) {
    const float lt = swap_add(l);
    LAS float* pm = (LAS float*)(lds + ST_M) + tau; LAS float* pl = (LAS float*)(lds + ST_L) + tau;
    float a1 = 0.f, a2 = 1.f, ln = lt, mn = m;
    if (MERGE) { const float m1 = *pm, l1 = *pl; mn = fmaxf(m, m1); a1 = l1 * __builtin_amdgcn_exp2f(m1 - mn); a2 = __builtin_amdgcn_exp2f(m - mn); ln = a1 + lt * a2; }
    const float rn = 1.0f / ln; a1 *= rn; a2 *= rn;
#pragma unroll
    for (int d0 = 0; d0 < 2; ++d0)
#pragma unroll
        for (int g = 0; g < 4; ++g) { LAS h16x4* p = dst_slot(lds, tau, 8 * d0 + 2 * g + hi);
            f32x4 v = d0 == 0 ? (f32x4){o0[4 * g], o0[4 * g + 1], o0[4 * g + 2], o0[4 * g + 3]} : (f32x4){o1[4 * g], o1[4 * g + 1], o1[4 * g + 2], o1[4 * g + 3]};
            v = v * a2;
            if (MERGE) { const h16x4 x = *p; v = v + (f32x4){(float)x[0], (float)x[1], (float)x[2], (float)x[3]} * a1; }
            *p = (h16x4){(_Float16)v[0], (_Float16)v[1], (_Float16)v[2], (_Float16)v[3]}; }
    if (hi == 0) { *pm = mn; *pl = ln; }
}
__device__ __forceinline__ void dstate_store(LAS char* lds, int w, int lane, bf16* orow0  ) {
#pragma unroll
    for (int i = 0; i < 8; ++i) { const int tau = 64 * w + 8 * i + (lane >> 3), pc = lane & 7;
        const h16x4 a = *dst_slot(lds, tau, 2 * pc), b = *dst_slot(lds, tau, 2 * pc + 1);
        v4u o; o.x = cvt2((float)a[0], (float)a[1]); o.y = cvt2((float)a[2], (float)a[3]); o.z = cvt2((float)b[0], (float)b[1]); o.w = cvt2((float)b[2], (float)b[3]);
        *(GAS v4u*)(orow0 + (size_t)tau * D + 8 * pc) = o; }
}

__device__ __forceinline__ void attn_phase(Frame& F) {
    LAS char* lds = (LAS char*)F.lds;
    const int w = F.wave;
    gu32* qhead = F.ctl + CW_QUEUE;
    volatile LAS unsigned* uw = F.MISC + 16;
    const size_t KV_OFF = (size_t)M * D * 2;
    const int myx = (int)(xb_xcc_id() & 7u);
    const int qmax = F.local ? 1 : 8;
    int qsel = 0;
#define ATT_POP(dst_) do { dst_ = 0xffffffffu; while (qsel < qmax) { const int xq_ = (myx + qsel) & 7; const unsigned i_ = __hip_atomic_fetch_add(qhead + 64 * xq_, 1u, __ATOMIC_RELAXED, __HIP_MEMORY_SCOPE_AGENT); \
        if (i_ < (unsigned)UNITS_PER_XCD) { dst_ = (unsigned)xq_ * UNITS_PER_XCD + i_; break; } ++qsel; } } while (0)
    if (F.tid == 0) { unsigned u0_; ATT_POP(u0_); uw[0] = u0_; }
    const unsigned dummy_dst = (unsigned)__builtin_amdgcn_readfirstlane((int)(unsigned)(size_t)(lds + ST_DUMMY + 256 * w));
    if (w >= 4) __builtin_amdgcn_s_setprio(1);
    for (int it = 0;; ++it) {
        __syncthreads();
        const unsigned ucode = (unsigned)__builtin_amdgcn_readfirstlane((int)uw[it & 1]);
        if (ucode == 0xffffffffu) break;
        unsigned unext = 0xffffffffu;
        if (F.tid == 0) ATT_POP(unext);
        const int xq = (int)(ucode / UNITS_PER_XCD), ui = (int)(ucode % UNITS_PER_XCD);
        int ub, uj;
        if (ui < 272) { const int bq = ui / 68, j = ui % 68; ub = 4 * xq + bq; uj = (j < 20) ? (j / 5) * 8 + (j % 5) : 32 + (j - 20); }
        else { const int k = ui - 272, idx = k & 15; ub = 4 * xq + (idx >> 2); uj = (idx & 3) * 8 + 5 + (k >> 4); }
        const bool is_moba = uj < 32;
        f32x16 o0, o1; float m, l; bf16x8 qf[4];
        int tl_ = F.tid; asm volatile("" : "+v"(tl_));
        const int lane = tl_ & 63, q = lane & 31, hi = lane >> 5, srow = lane >> 3, sch = lane & 7, tid512 = tl_;
        const int Lq = q - 4 * hi;
        f32x16 cr;
#pragma unroll
        for (int r = 0; r < 16; ++r) cr[r] = (float)ATT_CROW(r);
        if (is_moba) {
            ShC S;
            { const int row = tid512 >> 3, ch = tid512 & 7;
              S.kw = lds + row * 128 + ((ch ^ ((row >> 1) & 7)) << 4); S.vw = lds + 8192 + row * 128 + ((ch ^ (((row >> 1) & 1) << 2)) << 4);
#pragma unroll
              for (int ks = 0; ks < 4; ++ks) S.ka[ks] = lds + q * 128 + (((2 * ks + hi) ^ ((q >> 1) & 7)) << 4);
              const int q4 = (lane & 15) >> 2, p = lane & 3, blk = (lane >> 4) & 1, swz = ((q4 >> 1) & 1) << 6;
              S.va[0] = lds + 8192 + (4 * hi + q4) * 128 + swz + 32 * blk + 8 * p; S.va[1] = lds + 8192 + (4 * hi + q4) * 128 + (64 ^ swz) + 32 * blk + 8 * p; }
            const int n = 7 - (uj & 7), b = ub, hb = uj >> 3, hcol = (NHA + hb) * 64;
            const float sl2 = __builtin_amdgcn_exp2f(-2.0f * (float)(hb + 1)) * LOG2E;
            const f32x16 Kc = cr * sl2;
            const size_t row0 = (size_t)b * SEQ + 256 * n;
            load_q(qf, F.QB + (row0 + 32 * w + q) * D + hcol, hi);
            unsigned selmask = (1u << n) - 1u;
            if (n > 3) {
                const int rho = q, mrow = (rho & 3) + 4 * ((rho >> 3) & 1), part = rho >> 4;
                f32x16 g = (f32x16){0.f, 0.f, 0.f, 0.f, 0.f, 0.f, 0.f, 0.f, 0.f, 0.f, 0.f, 0.f, 0.f, 0.f, 0.f, 0.f};
                const float* ksrow = F.KS + (size_t)(b * 8 + mrow) * 256 + hb * 64;
#pragma unroll
                for (int ks = 0; ks < 4; ++ks) { const f32x4 x0 = *(const GAS f32x4*)(ksrow + 16 * ks + 8 * hi), x1 = *(const GAS f32x4*)(ksrow + 16 * ks + 8 * hi + 4);
                    const float xv[8] = {x0[0], x0[1], x0[2], x0[3], x1[0], x1[1], x1[2], x1[3]}; unsigned pk[4];
#pragma unroll
                    for (int e = 0; e < 4; ++e) { float a0 = xv[2 * e], a1 = xv[2 * e + 1];
                        const unsigned hp = cvt2(a0, a1);
                        if (part) { a0 -= __uint_as_float(hp << 16); a1 -= __uint_as_float(hp & 0xffff0000u); pk[e] = cvt2(a0, a1); } else pk[e] = hp; }
                    const v4u pv = {pk[0], pk[1], pk[2], pk[3]};
                    g = __builtin_amdgcn_mfma_f32_32x32x16_bf16(__builtin_bit_cast(bf16x8, pv), qf[ks], g, 0, 0, 0); }
                float gv[8];
#pragma unroll
                for (int e = 0; e < 8; ++e) gv[e] = g[e] + g[e + 8];
                selmask = 0u;
#pragma unroll
                for (int e = 0; e < 8; ++e) { int better = 0;
#pragma unroll
                    for (int e2 = 0; e2 < 8; ++e2) if (e2 != e) better += (e2 < n && (gv[e2] > gv[e] || (gv[e2] == gv[e] && e2 < e))) ? 1 : 0;
                    if (e < n && better < 3) selmask |= 1u << e; }
            }
            o0 = (f32x16){0.f, 0.f, 0.f, 0.f, 0.f, 0.f, 0.f, 0.f, 0.f, 0.f, 0.f, 0.f, 0.f, 0.f, 0.f, 0.f}; o1 = o0; m = -1e30f; l = 0.f;
            const int NR = 4 * (n + 1);
            const bf16* kbase = F.KB + ((size_t)b * SEQ + (tid512 >> 3)) * D + hcol + 8 * (tid512 & 7);
            v4u kr0, vr0, kr1, vr1, kr2, vr2, kr3, vr3;
#define SH_ISSUE(r_, KR, VR) do { const size_t off_ = (size_t)(256 * (n - ((r_) >> 2)) + 64 * (3 - ((r_) & 3))) * D; KR = *(const GAS v4u*)(kbase + off_); VR = *(const GAS v4u*)((const char*)(kbase + off_) + KV_OFF); } while (0)
#define SH_COMMIT(buf_, KR, VR) do { *(LAS v4u*)(S.kw + (buf_) * 16384) = KR; *(LAS v4u*)(S.vw + (buf_) * 16384) = VR; } while (0)
#define SH_BARRIER() do { asm volatile("s_waitcnt lgkmcnt(0)" ::: "memory"); __builtin_amdgcn_s_barrier(); asm volatile("" ::: "memory"); } while (0)
            SH_ISSUE(0, kr0, vr0); SH_ISSUE(1, kr1, vr1); SH_ISSUE(2, kr2, vr2); SH_ISSUE(3, kr3, vr3);
            SH_COMMIT(0, kr0, vr0); if (NR > 4) SH_ISSUE(4, kr0, vr0);
            SH_BARRIER();
#define SH_ROUND(RR, KRN, VRN) do { const int r = (RR); \
                const int bi = r >> 2, jj = 3 - (r & 3), bufo = (r & 1) * 16384; \
                const int DA = 256 * bi + 32 * w - 64 * jj, DB = DA - 32; \
                const bool lane_on = (bi == 0) ? true : (((selmask >> (n - bi)) & 1u) != 0u); \
                if (DA >= 0 && __any(lane_on)) { \
                    bf16x8 kfa[4], kfb[4]; \
_Pragma("unroll") \
                    for (int ks = 0; ks < 4; ++ks) { kfa[ks] = *(const LAS bf16x8*)(S.ka[ks] + bufo); kfb[ks] = *(const LAS bf16x8*)(S.ka[ks] + bufo + 4096); } \
                    ATT_SB(); \
                    f32x16 sA = Kc, sB = Kc; \
_Pragma("unroll") \
                    for (int ks = 0; ks < 4; ++ks) { sA = __builtin_amdgcn_mfma_f32_32x32x16_bf16(kfa[ks], qf[ks], sA, 0, 0, 0); sB = __builtin_amdgcn_mfma_f32_32x32x16_bf16(kfb[ks], qf[ks], sB, 0, 0, 0); } \
                    ATT_SB(); \
                    const float wlA = lane_on ? -(sl2 * (float)(DA + Lq)) : -INFINITY, wlB = (lane_on && DB >= 0) ? -(sl2 * (float)(DB + Lq)) : -INFINITY; \
                    if (bi == 0 && DA == 0) { \
_Pragma("unroll") \
                        for (int rr = 0; rr < 16; ++rr) sA[rr] = (ATT_CROW(rr) <= Lq) ? sA[rr] : -INFINITY; \
                    } \
                    if (bi == 0 && DB == 0) { \
_Pragma("unroll") \
                        for (int rr = 0; rr < 16; ++rr) sB[rr] = (ATT_CROW(rr) <= Lq) ? sB[rr] : -INFINITY; \
                    } \
                    softmax_tiles<true>(sA, sB, wlA, wlB, o0, o1, m, l); \
                    bf16x8 pa0, pa1, pb0, pb1; pack_p(sA, pa0, pa1); pack_p(sB, pb0, pb1); \
_Pragma("unroll") \
                    for (int d0 = 0; d0 < 2; ++d0) { LAS const char* vp_ = S.va[d0] + bufo; \
                        const s16x4 a0 = vtr(vp_), a1 = vtr(vp_ + 1024), a2 = vtr(vp_ + 2048), a3 = vtr(vp_ + 3072); \
                        const s16x4 b0 = vtr(vp_ + 4096), b1 = vtr(vp_ + 5120), b2 = vtr(vp_ + 6144), b3 = vtr(vp_ + 7168); \
                        if (d0 == 0) { o0 = __builtin_amdgcn_mfma_f32_32x32x16_bf16(ATT_VF(a0, a1), pa0, o0, 0, 0, 0); o0 = __builtin_amdgcn_mfma_f32_32x32x16_bf16(ATT_VF(a2, a3), pa1, o0, 0, 0, 0); \
                                       o0 = __builtin_amdgcn_mfma_f32_32x32x16_bf16(ATT_VF(b0, b1), pb0, o0, 0, 0, 0); o0 = __builtin_amdgcn_mfma_f32_32x32x16_bf16(ATT_VF(b2, b3), pb1, o0, 0, 0, 0); } \
                        else         { o1 = __builtin_amdgcn_mfma_f32_32x32x16_bf16(ATT_VF(a0, a1), pa0, o1, 0, 0, 0); o1 = __builtin_amdgcn_mfma_f32_32x32x16_bf16(ATT_VF(a2, a3), pa1, o1, 0, 0, 0); \
                                       o1 = __builtin_amdgcn_mfma_f32_32x32x16_bf16(ATT_VF(b0, b1), pb0, o1, 0, 0, 0); o1 = __builtin_amdgcn_mfma_f32_32x32x16_bf16(ATT_VF(b2, b3), pb1, o1, 0, 0, 0); } } \
                } \
                if (r + 1 < NR) { SH_COMMIT((r + 1) & 1, KRN, VRN); if (r + 5 < NR) SH_ISSUE(r + 5, KRN, VRN); } \
                SH_BARRIER(); } while (0)
#pragma nounroll
            for (int r0 = 0; r0 < NR; r0 += 4) { SH_ROUND(r0, kr1, vr1); SH_ROUND(r0 + 1, kr2, vr2); SH_ROUND(r0 + 2, kr3, vr3); SH_ROUND(r0 + 3, kr0, vr0); }
#undef SH_ROUND
#undef SH_ISSUE
#undef SH_COMMIT
#undef SH_BARRIER
            state_put<false>(lds, 32 * w + q, hi, o0, o1, m, l);
            state_store(lds, w, lane, F.OB + row0 * D + hcol);
        } else {
            LaneC C;
            { LAS char* kb = lds + w * 8192; LAS char* vb = kb + 4096; const int x0 = srow >> 1;
              C.kw_e = kb + srow * 128 + ((sch ^ x0) << 4); C.kw_o = kb + (srow + 8) * 128 + ((sch ^ (x0 + 4)) << 4); C.vw = vb + srow * 128 + ((sch ^ ((x0 & 1) << 2)) << 4);
#pragma unroll
              for (int ks = 0; ks < 4; ++ks) C.ka[ks] = kb + q * 128 + (((2 * ks + hi) ^ ((q >> 1) & 7)) << 4);
              const int q4 = (lane & 15) >> 2, p = lane & 3, blk = (lane >> 4) & 1, swz = ((q4 >> 1) & 1) << 6;
              C.va[0] = vb + (4 * hi + q4) * 128 + swz + 32 * blk + 8 * p; C.va[1] = vb + (4 * hi + q4) * 128 + (64 ^ swz) + 32 * blk + 8 * p; }
            const int u2 = uj - 32, c = 3 - (u2 & 3), b = ub, h = u2 >> 2, hcol = h * 64;
            const float sl2 = __builtin_amdgcn_exp2f(-0.5f * (float)(h + h / 3 + 1)) * LOG2E;
            const size_t brow = (size_t)b * SEQ; const int T0 = 512 * c;
#define DIL_PARAMS(rr, d_, ibase_, kcls_, nt_, win_) \
            const int d_ = ((rr) < 2) ? 1 : ((rr) < 4 ? 4 : 16); int ibase_, kcls_, nt_; bool win_; \
            if ((rr) < 2) { ibase_ = T0 + 64 * w + 32 * ((rr) & 1); kcls_ = 0; nt_ = min(5, ibase_ / 32 + 1); win_ = (nt_ == 5); } \
            else if ((rr) < 4) { ibase_ = T0 / 4 + 64 * (w & 1) + 32 * ((rr) & 1); kcls_ = w >> 1; nt_ = min(5, ibase_ / 32 + 1); win_ = (nt_ == 5); } \
            else { ibase_ = T0 / 16; kcls_ = 2 * w + ((rr) & 1); nt_ = c + 1; win_ = false; }
#define DIL_RO(r_) (((r_) < 2) ? (r_) + 4 : (((r_) < 4) ? (r_) : (r_) - 4))
#define DIL_KOFF(d_, ibase_, kcls_) ((unsigned)(((int)brow + (d_) * ((ibase_) + srow) + (kcls_)) * (D * 2) + hcol * 2 + 16 * sch))
#define DIL_QOFF(d_, ibase_, kcls_) ((unsigned)(((int)brow + (d_) * ((ibase_) + q) + (kcls_)) * (D * 2) + hcol * 2 + 16 * hi))
            const char* kbase = (const char*)F.KB; const char* vbase = kbase + KV_OFF; const char* qbase = (const char*)F.QB;
            bf16x8 qn[4]; v4u kst[4], vst[4];
            { DIL_PARAMS(DIL_RO(0), d0_, ib0_, kc0_, nt0_, win0_) (void)nt0_; (void)win0_;
              const unsigned ko_ = DIL_KOFF(d0_, ib0_, kc0_), rs0_ = 8u * d0_ * D * 2;
#pragma unroll
              for (int i_ = 0; i_ < 4; ++i_) kst[i_] = *(const GAS v4u*)(kbase + (size_t)(i_ * rs0_) + ko_);
              load_q_off(qn, qbase, DIL_QOFF(d0_, ib0_, kc0_));
#pragma unroll
              for (int i_ = 0; i_ < 4; ++i_) vst[i_] = *(const GAS v4u*)(vbase + (size_t)(i_ * rs0_) + ko_); }
#pragma unroll
            for (int r = 0; r < 6; ++r) {
                const int ro = DIL_RO(r);
                DIL_PARAMS(ro, d, ibase, kcls, nt, win)
                const int rn = DIL_RO((r < 5) ? r + 1 : 5);
                DIL_PARAMS(rn, dn, ibn, kcn, ntn, winn) (void)ntn; (void)winn;
                const int sub = ro & 1;
                const int tau = (ro < 2) ? 64 * w + 32 * sub + q : (ro < 4 ? 4 * (64 * (w & 1) + 32 * sub + q) + kcls : 16 * q + kcls);
                const float sl2d = sl2 * (float)d;
#pragma unroll
                for (int ks = 0; ks < 4; ++ks) qf[ks] = qn[ks];
                o0 = (f32x16){0.f, 0.f, 0.f, 0.f, 0.f, 0.f, 0.f, 0.f, 0.f, 0.f, 0.f, 0.f, 0.f, 0.f, 0.f, 0.f}; o1 = o0; m = -1e30f; l = 0.f;
                const f32x16 Kc = cr * sl2d;
                Run R;
                R.tstep = (unsigned)(-(32 * d * D * 2)); R.rstride = 8u * d * D * 2; R.nt = nt;
                R.off = DIL_KOFF(d, ibase, kcls) + R.tstep;
                R.wl0 = -(sl2d * (float)Lq); R.wstep = sl2d * 32.f;
                R.thr_c = Lq; R.thr_w = Lq; R.causal_first = true; R.window_last = win;
                R.noff = DIL_KOFF(dn, ibn, kcn); R.nrstride = 8u * dn * D * 2; R.nqoff = DIL_QOFF(dn, ibn, kcn);
                run_tiles(C, R, kbase, vbase, qbase, qf, qn, kst, vst, Kc, o0, o1, m, l);
                if (r < 2) dstate_put<false>(lds, tau, hi, o0, o1, m, l); else dstate_put<true>(lds, tau, hi, o0, o1, m, l);
                if (r == 1 || r == 3) { asm volatile("s_waitcnt lgkmcnt(0)" ::: "memory"); __builtin_amdgcn_s_barrier(); asm volatile("" ::: "memory"); }
            }
#undef DIL_PARAMS
#undef DIL_KOFF
#undef DIL_RO
#undef DIL_QOFF
            dstate_store(lds, w, lane, F.OB + (brow + T0) * D + hcol);
        }
        if (F.tid == 0) uw[(it + 1) & 1] = unext;
    }
    __builtin_amdgcn_s_setprio(0);
}
#undef ATT_POP
#undef ATT_CROW
#undef ATT_SB
#undef ATT_VF
}
struct Args { const float* in[15]; float* out; unsigned char* ws; };
__global__ void __launch_bounds__(NWAVES * 64, 2) fwd_kernel(Args args) {
    extern __shared__ __attribute__((aligned(16))) unsigned char lds[];
    Frame F;
    F.lds = (LAS unsigned char*)lds;
    F.MISC = (volatile LAS unsigned*)(F.lds + MISC_OFF);
    F.tid = threadIdx.x; F.lane = F.tid & 63; F.wave = __builtin_amdgcn_readfirstlane(F.tid >> 6);
    F.G = gridDim.x; { const int bx = blockIdx.x; F.vcu = (F.G % 8 == 0) ? (bx % 8) * (F.G / 8) + bx / 8 : bx; }
    unsigned char* ws = args.ws;
    F.ctl = (gu32*)(ws + WS_CTL);
    F.x = args.in[0]; F.g1w = args.in[1]; F.u1w = args.in[2]; F.d1w = args.in[3]; F.ln1g = args.in[4]; F.ln1b = args.in[5]; F.win = args.in[6]; F.wout = args.in[7];
    F.ln2g = args.in[8]; F.ln2b = args.in[9]; F.g2w = args.in[10]; F.u2w = args.in[11]; F.d2w = args.in[12]; F.ln3g = args.in[13]; F.ln3b = args.in[14]; F.out = args.out;
    F.W1T = (bf16*)(ws + WS_W1T); F.W2T = (bf16*)(ws + WS_W2T); F.WINT = (bf16*)(ws + WS_WINT); F.WOT = (bf16*)(ws + WS_WOT); F.W3T = (bf16*)(ws + WS_W3T); F.W4T = (bf16*)(ws + WS_W4T);
    F.AB = (bf16*)(ws + WS_AB); F.YH = (unsigned short*)(ws + WS_YH); F.HB = (bf16*)(ws + WS_R1);
    F.QB = (bf16*)(ws + WS_OB); F.KB = (bf16*)args.out; F.VB = F.KB + (size_t)M * D;
    F.OB = (bf16*)(ws + WS_OB); F.KS = (float*)(ws + WS_KS);
    F.CSIN = (float*)(ws + WS_VEC); F.BWIN = F.CSIN + NQKV; F.CS3 = F.BWIN + NQKV; F.BW3 = F.CS3 + NGU;
    F.PS1 = (pg8::f32x2v*)(ws + WS_PS); F.PS2 = F.PS1 + (size_t)M * 4; F.PS3 = F.PS2 + (size_t)M * 4; F.RS1 = (pg8::f32x2v*)(ws + WS_RS); F.RS2 = F.RS1 + M;
    for (int u = F.tid; u < (LDS_BYTES - LDSCTL_OFF) / 4; u += NWAVES * 64) ((LAS unsigned*)(F.lds + LDSCTL_OFF))[u] = 0u;
    __syncthreads();
    XcdBarrier bar = xcd_barrier_post((unsigned*)(F.ctl + CW_BAR), F.MISC + 8);
    if (F.tid == 0 && (bar.x != (blockIdx.x & 7u) || F.G != 256)) (void)xb_add((unsigned*)(F.ctl + CW_BAD), 1u);
    F.local = 0;
    gu32* lcnt = F.ctl + CW_LBAR + 64 * (blockIdx.x & 7u);

    p0_prologue(F);
    xcd_barrier(bar);
    F.local = __builtin_amdgcn_readfirstlane((int)(xb_ld((unsigned*)(F.ctl + CW_BAD)) == 0u));
    if (F.local) {
        for (unsigned i_ = 0; i_ < (blockIdx.x & 7u) * XCD_SKEW; ++i_) __builtin_amdgcn_s_sleep(64);
    }
    { pg8::Gemm g{F.AB, F.W1T, M, NGU, D}; pg8::StaticOrder S; S.init(M, NGU, F.G, (int)blockIdx.x);
      pg8::EpiSwiGLU<false> E{F.HB, FF, pg8::LnFold{(PG8_LAS const pg8::f32x2v*)nullptr, nullptr, nullptr}};
      pg8::gemm_phase<pg8::EpiSwiGLU<false>, pg8::StaticOrder, true, PG8_SP2>(F.lds + RING_OFF, g, S, E); }
    seam(bar, F.local, lcnt, 1u * 32u);
    { pg8::Gemm g{F.HB, F.W2T, M, D, FF}; pg8::StaticOrder S; S.init(M, D, F.G, (int)blockIdx.x);
      pg8::EpiRes<false, false, true> E{F.x, nullptr, F.YH, F.PS1, (PG8_LAS const pg8::f32x2v*)nullptr, nullptr, nullptr, ALPHA, 0.5f};
      pg8::gemm_phase<pg8::EpiRes<false, false, true>, pg8::StaticOrder, true, PG8_SP2>(F.lds + RING_OFF, g, S, E); }
    seam(bar, F.local, lcnt, 2u * 32u);
    { pg8::Gemm g{(const pg8::bf16_t*)F.YH, F.WINT, M, NQKV, D};     pg8::StaticOrder S; S.init(M, NQKV, F.G, (int)blockIdx.x);
      { pg8::Unit u0; S.next(0, u0); fill_row_stats(F, F.PS1, u0.pm); }
      pg8::EpiQKV E{F.QB, F.KB, (size_t)M * D, QSCALE, F.KS, pg8::LnFold{(PG8_LAS const pg8::f32x2v*)(F.lds + RSL_OFF), F.CSIN, F.BWIN}};
      pg8::gemm_phase<pg8::EpiQKV, pg8::StaticOrder, true, PG8_SP2>(F.lds + RING_OFF, g, S, E); }
    seam(bar, F.local, lcnt, 3u * 32u);
    att::attn_phase(F);
    seam(bar, F.local, lcnt, 4u * 32u);
    if (F.tid == 0) (void)xb_add((unsigned*)(F.ctl + CW_ADONE), 1u);
    { pg8::Gemm g{F.OB, F.WOT, M, D, D}; pg8::StaticOrder S; S.init(M, D, F.G, (int)blockIdx.x);
      { pg8::Unit u0; S.next(0, u0); fill_row_stats(F, F.PS1, u0.pm); }
      pg8::EpiRes<true, true, true> E{nullptr, nullptr, F.YH, F.PS2, (PG8_LAS const pg8::f32x2v*)(F.lds + RSL_OFF), F.ln1g, F.ln1b, ALPHA, 1.0f};
      pg8::gemm_phase<pg8::EpiRes<true, true, true>, pg8::StaticOrder, true, PG8_SP2>(F.lds + RING_OFF, g, S, E); }
    seam(bar, F.local, lcnt, 5u * 32u);
    { pg8::Gemm g{(const pg8::bf16_t*)F.YH, F.W3T, M, NGU, D};     pg8::StaticOrder S; S.init(M, NGU, F.G, (int)blockIdx.x);
      { pg8::Unit u0; S.next(0, u0); fill_row_stats(F, F.PS2, u0.pm); }
      pg8::EpiSwiGLU<true> E{F.HB, FF, pg8::LnFold{(PG8_LAS const pg8::f32x2v*)(F.lds + RSL_OFF), F.CS3, F.BW3}};
      pg8::gemm_phase<pg8::EpiSwiGLU<true>, pg8::StaticOrder, true, PG8_SP2>(F.lds + RING_OFF, g, S, E); }
    seam(bar, F.local, lcnt, 6u * 32u);
    { pg8::Gemm g{F.HB, F.W4T, M, D, FF}; pg8::StaticOrder S; S.init(M, D, F.G, (int)blockIdx.x);
      { pg8::Unit u0; S.next(0, u0); fill_row_stats(F, F.PS2, u0.pm); }
      pg8::EpiRes<true, true, false> E{nullptr, nullptr, F.YH, F.PS3, (PG8_LAS const pg8::f32x2v*)(F.lds + RSL_OFF), F.ln2g, F.ln2b, ALPHA, 0.5f};
      pg8::gemm_phase<pg8::EpiRes<true, true, false>, pg8::StaticOrder, true, PG8_SP2>(F.lds + RING_OFF, g, S, E); }
    if (F.local) {
        seam(bar, 1, lcnt, 7u * 32u);
        if (F.tid == 0) XB_SPIN(xb_ld((unsigned*)(F.ctl + CW_ADONE)) < (unsigned)F.G, bar.bar);
        __syncthreads();
    } else xcd_barrier(bar);
    final_phase(F);
}

extern "C" void kernel_launch(void* const* d_in, const int* in_sizes, int n_in, void* d_out, int out_size, void* d_ws, size_t ws_size, hipStream_t stream) {
    static int grid = 0;
    if (grid == 0) {
        if (n_in != 15 || in_sizes[0] != M * D || out_size != M * D || ws_size < WS_END) { fprintf(stderr, "kernel_launch: shape/workspace mismatch (n_in %d, in0 %d, out %d, ws %zu)\n", n_in, n_in > 0 ? in_sizes[0] : -1, out_size, ws_size); grid = -1; return; }
        int dev = 0, cus = 0, per_cu = 0;
        if (hipGetDevice(&dev) != hipSuccess || hipDeviceGetAttribute(&cus, hipDeviceAttributeMultiprocessorCount, dev) != hipSuccess) { grid = -1; return; }
        if (hipFuncSetAttribute((const void*)fwd_kernel, hipFuncAttributeMaxDynamicSharedMemorySize, LDS_BYTES) != hipSuccess) { fprintf(stderr, "kernel_launch: hipFuncSetAttribute failed\n"); grid = -1; return; }
        if (hipOccupancyMaxActiveBlocksPerMultiprocessor(&per_cu, (const void*)fwd_kernel, NWAVES * 64, LDS_BYTES) != hipSuccess || per_cu < 1) { fprintf(stderr, "kernel_launch: occupancy query reports %d\n", per_cu); }
        (void)hipGetLastError();
        grid = cus;
    }
    if (grid < 0) return;
    if (hipMemsetAsync((char*)d_ws + WS_CTL, 0, CTL_ZERO_BYTES, stream) != hipSuccess) return;
    Args a{};
    for (int i = 0; i < 15; ++i) a.in[i] = (const float*)d_in[i];
    a.out = (float*)d_out; a.ws = (unsigned char*)d_ws;
    hipLaunchKernelGGL(fwd_kernel, dim3(grid), dim3(NWAVES * 64), LDS_BYTES, stream, a);
}
```
